# Optimizing an MI355X kernel written in HIP

```python
import jax, jax.numpy as jnp
from jax import lax
import numpy as np

D_MODEL = 1024
BATCH = 8
SEQ = 2048
DEPTH = 1
DEC_BATCH = 16
DEC_SEQ = 2048
PAST_LEN = 128

GRID_W = 64
EPS = 1e-6
ATT_HEADS = 8
ATT_KV_HEADS = 2
ATT_GROUP = ATT_HEADS // ATT_KV_HEADS
ATT_HEAD_DIM = 64
ROPE_AXIS_DIM = ATT_HEAD_DIM // 2
ROPE_THETA = 10000.0
Q_BLOCK = 128
M_HEADS = 4
M_HEAD_DIM = 128
M_CHUNK = 64
FORGET_BIAS_LO = 3.0
FORGET_BIAS_HI = 6.0
D_FF = 2816
ATT_WIDTH = ATT_HEADS * ATT_HEAD_DIM
KV_WIDTH = ATT_KV_HEADS * ATT_HEAD_DIM
M_WIDTH = M_HEADS * M_HEAD_DIM
N_GATE_COLS = 4 * M_HEADS
IN_SPLITS = (ATT_WIDTH, KV_WIDTH, KV_WIDTH, M_WIDTH, M_WIDTH, M_WIDTH, N_GATE_COLS, M_WIDTH, D_MODEL, D_MODEL)
D_IN = sum(IN_SPLITS)

kernel_name = 'hybrid_gqa_mlstm_macaron_encoder'


def rms_norm(x, g):
    xf = x.astype(jnp.float32)
    y = xf * lax.rsqrt(jnp.mean(xf * xf, axis=-1, keepdims=True) + EPS)
    return (y * g.astype(jnp.float32)).astype(x.dtype)


def swiglu(x, w_gate, w_up, w_down):
    return (jax.nn.silu(x @ w_gate) * (x @ w_up)) @ w_down


def axial_rope_angles(seq_len):
    rows = seq_len // GRID_W
    row = jnp.repeat(jnp.arange(rows, dtype=jnp.float32), GRID_W)
    col = jnp.tile(jnp.arange(GRID_W, dtype=jnp.float32), rows)
    inv_freq = ROPE_THETA ** (-jnp.arange(0, ROPE_AXIS_DIM, 2, dtype=jnp.float32) / ROPE_AXIS_DIM)
    ang = jnp.concatenate([row[:, None] * inv_freq, col[:, None] * inv_freq], axis=-1)
    return jnp.cos(ang), jnp.sin(ang)


def apply_rope(x, cos, sin):
    xf = x.astype(jnp.float32).reshape(x.shape[:-1] + (ATT_HEAD_DIM // 2, 2))
    x0, x1 = xf[..., 0], xf[..., 1]
    c, s = cos[None, :, None, :], sin[None, :, None, :]
    out = jnp.stack([x0 * c - x1 * s, x0 * s + x1 * c], axis=-1)
    return out.reshape(x.shape).astype(x.dtype)


def gqa_block_attention(q, k, v):
    B, S = q.shape[:2]
    nb = S // Q_BLOCK
    qb = q.reshape(B, nb, Q_BLOCK, ATT_KV_HEADS, ATT_GROUP, ATT_HEAD_DIM).transpose(1, 0, 2, 3, 4, 5)
    scale = ATT_HEAD_DIM ** -0.5

    def one_block(qi):
        s = jnp.einsum('bqkgd,bskd->bkgqs', qi, k, preferred_element_type=jnp.float32) * scale
        p = jax.nn.softmax(s, axis=-1).astype(v.dtype)
        return jnp.einsum('bkgqs,bskd->bqkgd', p, v)

    o = lax.map(one_block, qb)
    return o.transpose(1, 0, 2, 3, 4, 5).reshape(B, S, ATT_WIDTH)


def mlstm_direction(q, k, v, logi, logf):
    B, H, S, d = q.shape
    nc = S // M_CHUNK

    def chunks(a):
        a = a.reshape((B, H, nc, M_CHUNK) + a.shape[3:])
        return jnp.moveaxis(a, 2, 0)

    tril = jnp.tril(jnp.ones((M_CHUNK, M_CHUNK), dtype=bool))

    def step(carry, inp):
        C, n, m = carry
        qc, kc, vc, li, lf = inp
        b = jnp.cumsum(lf, axis=-1)
        D = b[..., :, None] - b[..., None, :] + li[..., None, :]
        D = jnp.where(tril, D, -jnp.inf)
        inter = b + m[..., None]
        m_t = jnp.maximum(inter, jnp.max(D, axis=-1))
        w_inter = jnp.exp(inter - m_t)
        S_qk = jnp.einsum('bhtd,bhsd->bhts', qc, kc) * jnp.exp(D - m_t[..., None])
        num = jnp.einsum('bhts,bhse->bhte', S_qk, vc) + w_inter[..., None] * jnp.einsum('bhtd,bhde->bhte', qc, C)
        den = jnp.sum(S_qk, axis=-1) + w_inter * jnp.einsum('bhtd,bhd->bht', qc, n)
        h = num / jnp.maximum(jnp.abs(den), jnp.exp(-m_t))[..., None]
        bL = b[..., -1]
        g = bL[..., None] - b + li
        m_new = jnp.maximum(bL + m, jnp.max(g, axis=-1))
        w_old = jnp.exp(bL + m - m_new)
        w_s = jnp.exp(g - m_new[..., None])
        C_new = w_old[..., None, None] * C + jnp.einsum('bhs,bhsd,bhse->bhde', w_s, kc, vc)
        n_new = w_old[..., None] * n + jnp.einsum('bhs,bhsd->bhd', w_s, kc)
        return (C_new, n_new, m_new), h

    init = (jnp.zeros((B, H, d, d), jnp.float32), jnp.zeros((B, H, d), jnp.float32), jnp.zeros((B, H), jnp.float32))
    _, h = lax.scan(step, init, (chunks(q), chunks(k), chunks(v), chunks(logi), chunks(logf)))
    return jnp.moveaxis(h, 0, 2).reshape(B, H, S, d)


def mlstm_bidirectional(q, k, v, gate_pre, gate_bias, o_pre, head_norm):
    B, S, _ = q.shape

    def to_heads(a):
        return a.astype(jnp.float32).reshape(B, S, M_HEADS, M_HEAD_DIM).transpose(0, 2, 1, 3)

    qh, kh, vh = to_heads(q), to_heads(k) * (M_HEAD_DIM ** -0.5), to_heads(v)
    gp = (gate_pre.astype(jnp.float32) + gate_bias.astype(jnp.float32)).reshape(B, S, 4, M_HEADS).transpose(2, 0, 3, 1)
    i_fwd, f_fwd = gp[0], jax.nn.log_sigmoid(gp[1])
    i_bwd, f_bwd = gp[2], jax.nn.log_sigmoid(gp[3])
    h_fwd = mlstm_direction(qh, kh, vh, i_fwd, f_fwd)

    def flip(a):
        return jnp.flip(a, axis=2)

    h_bwd = flip(mlstm_direction(flip(qh), flip(kh), flip(vh), flip(i_bwd), flip(f_bwd)))
    h = (h_fwd + h_bwd).transpose(0, 2, 1, 3)
    h = h * lax.rsqrt(jnp.mean(h * h, axis=-1, keepdims=True) + EPS)
    h = h.reshape(B, S, M_WIDTH) * head_norm.astype(jnp.float32)
    return (jax.nn.sigmoid(o_pre.astype(jnp.float32)) * h).astype(q.dtype)


def encoder_layer(x, cos, sin, ffn1_norm, ffn1_w_gate, ffn1_w_up, ffn1_w_down, mix_norm, w_in, q_norm, k_norm,
                  mlstm_gate_bias, mlstm_head_norm, w_up_att, w_up_mlstm, w_out,
                  ffn2_norm, ffn2_w_gate, ffn2_w_up, ffn2_w_down):
    B, S, _ = x.shape
    x = x + 0.5 * swiglu(rms_norm(x, ffn1_norm), ffn1_w_gate, ffn1_w_up, ffn1_w_down)
    h = rms_norm(x, mix_norm)
    proj = h @ w_in
    split_at = [int(i) for i in np.cumsum(IN_SPLITS)[:-1]]
    aq, ak, av, mq, mk, mv, gate_pre, o_pre, g_att, g_mlstm = jnp.split(proj, split_at, axis=-1)
    aq = apply_rope(rms_norm(aq.reshape(B, S, ATT_HEADS, ATT_HEAD_DIM), q_norm), cos, sin)
    ak = apply_rope(rms_norm(ak.reshape(B, S, ATT_KV_HEADS, ATT_HEAD_DIM), k_norm), cos, sin)
    av = av.reshape(B, S, ATT_KV_HEADS, ATT_HEAD_DIM)
    att = gqa_block_attention(aq, ak, av)
    mem = mlstm_bidirectional(mq, mk, mv, gate_pre, mlstm_gate_bias, o_pre, mlstm_head_norm)
    merged = jax.nn.sigmoid(g_att) * (att @ w_up_att) + jax.nn.sigmoid(g_mlstm) * (mem @ w_up_mlstm)
    x = x + merged @ w_out
    x = x + 0.5 * swiglu(rms_norm(x, ffn2_norm), ffn2_w_gate, ffn2_w_up, ffn2_w_down)
    return x


def trunk(x, ffn1_norm, ffn1_w_gate, ffn1_w_up, ffn1_w_down, mix_norm, w_in, q_norm, k_norm,
          mlstm_gate_bias, mlstm_head_norm, w_up_att, w_up_mlstm, w_out,
          ffn2_norm, ffn2_w_gate, ffn2_w_up, ffn2_w_down, final_norm):
    cos, sin = axial_rope_angles(x.shape[1])
    for l in range(DEPTH):
        x = encoder_layer(x, cos, sin, ffn1_norm[l], ffn1_w_gate[l], ffn1_w_up[l], ffn1_w_down[l], mix_norm[l],
                          w_in[l], q_norm[l], k_norm[l], mlstm_gate_bias[l], mlstm_head_norm[l], w_up_att[l],
                          w_up_mlstm[l], w_out[l], ffn2_norm[l], ffn2_w_gate[l], ffn2_w_up[l], ffn2_w_down[l])
    return rms_norm(x, final_norm)


def setup_inputs(seed: int = 0) -> dict:
    key = jax.random.key(seed)
    ks = jax.random.split(key, 24)
    L = DEPTH

    def dense(k, fan_in, shape):
        return jax.random.normal(k, shape, jnp.float32) * (fan_in ** -0.5)

    def gain(k, shape):
        return 1.0 + 0.02 * jax.random.normal(k, shape, jnp.float32)

    b_i = 0.1 * jax.random.normal(ks[20], (L, 2, M_HEADS), jnp.float32)
    b_f = jnp.linspace(FORGET_BIAS_LO, FORGET_BIAS_HI, M_HEADS, dtype=jnp.float32)[None, None, :] \
        + 0.1 * jax.random.normal(ks[21], (L, 2, M_HEADS), jnp.float32)
    gate_bias = jnp.stack([b_i[:, 0], b_f[:, 0], b_i[:, 1], b_f[:, 1]], axis=1).reshape(L, N_GATE_COLS)
    return {
        'x_prompt': jax.random.normal(ks[0], (BATCH, SEQ, D_MODEL), jnp.float32),
        'x_sample': jax.random.normal(ks[1], (DEC_BATCH, DEC_SEQ, D_MODEL), jnp.float32),
        'ffn1_norm': gain(ks[2], (L, D_MODEL)),
        'ffn1_w_gate': dense(ks[3], D_MODEL, (L, D_MODEL, D_FF)),
        'ffn1_w_up': dense(ks[4], D_MODEL, (L, D_MODEL, D_FF)),
        'ffn1_w_down': dense(ks[5], D_FF, (L, D_FF, D_MODEL)),
        'mix_norm': gain(ks[6], (L, D_MODEL)),
        'w_in': dense(ks[7], D_MODEL, (L, D_MODEL, D_IN)),
        'q_norm': gain(ks[8], (L, ATT_HEAD_DIM)),
        'k_norm': gain(ks[9], (L, ATT_HEAD_DIM)),
        'mlstm_gate_bias': gate_bias,
        'mlstm_head_norm': gain(ks[10], (L, M_WIDTH)),
        'w_up_att': dense(ks[11], ATT_WIDTH, (L, ATT_WIDTH, D_MODEL)),
        'w_up_mlstm': dense(ks[12], M_WIDTH, (L, M_WIDTH, D_MODEL)),
        'w_out': dense(ks[13], D_MODEL, (L, D_MODEL, D_MODEL)),
        'ffn2_norm': gain(ks[14], (L, D_MODEL)),
        'ffn2_w_gate': dense(ks[15], D_MODEL, (L, D_MODEL, D_FF)),
        'ffn2_w_up': dense(ks[16], D_MODEL, (L, D_MODEL, D_FF)),
        'ffn2_w_down': dense(ks[17], D_FF, (L, D_FF, D_MODEL)),
        'final_norm': gain(ks[18], (D_MODEL,)),
    }


def reference(x_prompt, x_sample, ffn1_norm, ffn1_w_gate, ffn1_w_up, ffn1_w_down, mix_norm, w_in, q_norm, k_norm,
              mlstm_gate_bias, mlstm_head_norm, w_up_att, w_up_mlstm, w_out,
              ffn2_norm, ffn2_w_gate, ffn2_w_up, ffn2_w_down, final_norm):
    y_prompt = trunk(x_prompt, ffn1_norm, ffn1_w_gate, ffn1_w_up, ffn1_w_down, mix_norm, w_in, q_norm, k_norm,
                     mlstm_gate_bias, mlstm_head_norm, w_up_att, w_up_mlstm, w_out,
                     ffn2_norm, ffn2_w_gate, ffn2_w_up, ffn2_w_down, final_norm)
    y_sample = trunk(x_sample, ffn1_norm, ffn1_w_gate, ffn1_w_up, ffn1_w_down, mix_norm, w_in, q_norm, k_norm,
                     mlstm_gate_bias, mlstm_head_norm, w_up_att, w_up_mlstm, w_out,
                     ffn2_norm, ffn2_w_gate, ffn2_w_up, ffn2_w_down, final_norm)
    return (y_prompt, y_sample)
```

```cpp
#include <hip/hip_runtime.h>
#include <hip/hip_cooperative_groups.h>
#include <cstdio>
#include <cstdint>
namespace pg8 {
#define PG8_LAS __attribute__((address_space(3)))
typedef unsigned short bf16_t;
typedef short bf16x8 __attribute__((ext_vector_type(8)));
typedef float f32x4 __attribute__((ext_vector_type(4)));
typedef unsigned u32x4 __attribute__((ext_vector_type(4)));
constexpr int BM = 256, BK = 64, HALF = 128, HTB = HALF * BK * 2  , STAGE_BYTES = 8 * HTB, NXCD = 8, WGM = 8;

__host__ __device__ __forceinline__ int lds_byte(int r, int c) { const int st = (r >> 4) * 2 + (c >> 5), rr = r & 15, cc = c & 31, ob = rr * 64 + cc * 2; return st * 1024 + (ob ^ (((ob >> 9) & 1) << 5)); }
__host__ __device__ __forceinline__ void stage_rc(int b, int& R, int& C) { const int st = b / 1024, sb = b % 1024, swz = sb ^ (((sb >> 9) & 1) << 5); R = (st >> 1) * 16 + swz / 64; C = (st & 1) * 32 + (swz % 64) / 2; }
__host__ __device__ __forceinline__ int perm32(int rho) { const int n = rho >> 4, i = rho & 15; return 8 * (i >> 2) + 4 * n + (i & 3); }

struct Unit { int pm, pn; };
struct Gemm { const bf16_t* A; const bf16_t* Bt; int M, N, K; };

struct StaticOrder {
    int nM, nN, nwg, G, c;
    __host__ __device__ void init(int M, int N, int G_, int c_) { nM = M / BM; nN = N / BM; nwg = nM * nN; G = G_; c = c_; }
    __host__ __device__ bool next(int i, Unit& u) const {
        const long L = (long)i * G + c; if (L >= nwg) return false;
        int wgid = (int)L; { const int q = nwg / NXCD, r = nwg % NXCD, xcd = wgid % NXCD, off = wgid / NXCD; wgid = (xcd < r ? xcd * (q + 1) : r * (q + 1) + (xcd - r) * q) + off; }
        const int nig = WGM * nN, gid = wgid / nig, fm = gid * WGM, gsz = (nM - fm) < WGM ? (nM - fm) : WGM;
        u.pm = fm + ((wgid % nig) % gsz); u.pn = (wgid % nig) / gsz; return true;
    }
    __device__ __forceinline__ void a_ready(const Unit&) const {}
    __device__ __forceinline__ void done(const Unit&) const {}
};

struct HalfOrder {
    StaticOrder so;
    __host__ __device__ void init(int M, int N, int G_, int c_) { so.init(M, N, G_, c_); }
    __host__ __device__ bool next(int i, Unit& u) const { if (!so.next(i >> 1, u)) return false; if (i & 1) { u.pm += so.nM; u.pn += so.nN; } return true; }
    __device__ __forceinline__ void a_ready(const Unit&) const {}
    __device__ __forceinline__ void done(const Unit&) const {}
};
__device__ __forceinline__ unsigned cvt_pk_bf16(float lo, float hi) { unsigned r; asm volatile("v_cvt_pk_bf16_f32 %0, %1, %2" : "=v"(r) : "v"(lo), "v"(hi)); return r; }
typedef float f32x2 __attribute__((ext_vector_type(2)));
enum { M_SWIGLU = 1, M_RES = 2, M_WINA = 3, M_KVT = 4, M_GAGM = 5, M_UPA = 6, M_UPM = 7, M_UPF = 8 };
__device__ __forceinline__ float sigm(float v) { return __builtin_amdgcn_rcpf(1.0f + __builtin_amdgcn_exp2f(-1.4426950408889634f * v)); }
__device__ __forceinline__ u32x4 pack8(f32x4 a, f32x4 b) { u32x4 w; w.x = cvt_pk_bf16(a[0], a[1]); w.y = cvt_pk_bf16(a[2], a[3]); w.z = cvt_pk_bf16(b[0], b[1]); w.w = cvt_pk_bf16(b[2], b[3]); return w; }
__device__ __forceinline__ void unpack8(u32x4 w, f32x4& a, f32x4& b) {
    a[0] = __uint_as_float(w.x << 16); a[1] = __uint_as_float(w.x & 0xffff0000u); a[2] = __uint_as_float(w.y << 16); a[3] = __uint_as_float(w.y & 0xffff0000u);
    b[0] = __uint_as_float(w.z << 16); b[1] = __uint_as_float(w.z & 0xffff0000u); b[2] = __uint_as_float(w.w << 16); b[3] = __uint_as_float(w.w & 0xffff0000u); }
constexpr int TOK = 49152, NPROMPT = 16384;
__device__ __forceinline__ int sigma32e(int r) { return (r & 19) | ((r & 4) << 1) | ((r & 8) >> 1); }
template <int mode, int reskind = 0, int wf32 = 0, int wbf = 0> struct EpiG {
    static constexpr bool PERM = true, AFTER_DRAIN = false, HAS_MID = (mode == M_UPF);
    const float* ssin; float* ssout; const float* x0; const float* x1; float* f32buf;
    bf16_t* b0; bf16_t* q; bf16_t* kv; bf16_t* mqk; bf16_t* opre; float* g16; const bf16_t* gate;
    const float* qnw; const float* knw; const float* ropec; const float* ropes;
    __device__ __forceinline__ bool is_first_half(const Unit& u) const { return u.pm < TOK / BM; }
    __device__ __forceinline__ void mid(f32x4 (&acc)[2][2][4][2], const Unit& u, int wr, int wc, int fr, int fq) const {
        const int rowb = u.pm * BM + wr * 64 + fr; const int cw = wc * 32 + 8 * fq;
#pragma unroll
        for (int ai = 0; ai < 2; ++ai)
#pragma unroll
            for (int mh = 0; mh < 2; ++mh) {
                u32x4 ga[2][2], gm[2][2];
#pragma unroll
                for (int mm = 0; mm < 2; ++mm) { const int row = rowb + ai * HALF + (2 * mh + mm) * 16;
#pragma unroll
                    for (int bj = 0; bj < 2; ++bj) { const size_t o = (size_t)row * 1024 + u.pn * BM + bj * HALF + cw; ga[mm][bj] = *(const u32x4*)(q + o); gm[mm][bj] = *(const u32x4*)(gate + o); } }
                asm volatile("" ::: "memory");
#pragma unroll
                for (int mm = 0; mm < 2; ++mm)
#pragma unroll
                    for (int bj = 0; bj < 2; ++bj) { const int m = 2 * mh + mm; f32x4 a0, a1, m0, m1; unpack8(ga[mm][bj], a0, a1); unpack8(gm[mm][bj], m0, m1);
#pragma unroll
                        for (int i = 0; i < 4; ++i) { acc[ai][bj][m][0][i] *= a0[i] * __builtin_amdgcn_rcpf(m0[i]); acc[ai][bj][m][1][i] *= a1[i] * __builtin_amdgcn_rcpf(m1[i]); } }
                asm volatile("" ::: "memory"); }
    }
    __device__ __forceinline__ void operator()(const f32x4 (&acc)[2][2][4][2], const Unit& u, int wr, int wc, int fr, int fq) const {
        const int rowb = u.pm * BM + wr * 64 + fr;
        const int cw = wc * 32 + 8 * fq;
        if (mode == M_SWIGLU) {
#pragma unroll
            for (int ai = 0; ai < 2; ++ai)
#pragma unroll
                for (int m = 0; m < 4; ++m) { const int row = rowb + ai * HALF + m * 16; const float r = rsqrtf(ssin[row] * (1.0f / 1024.0f) + 1e-6f);
                    f32x4 g0 = acc[ai][0][m][0] * r, g1 = acc[ai][0][m][1] * r, u0 = acc[ai][1][m][0] * r, u1 = acc[ai][1][m][1] * r;
#pragma unroll
                    for (int i = 0; i < 4; ++i) { g0[i] = g0[i] * sigm(g0[i]) * u0[i]; g1[i] = g1[i] * sigm(g1[i]) * u1[i]; }
                    *(u32x4*)(b0 + (size_t)row * 2816 + u.pn * 128 + cw) = pack8(g0, g1); }
        } else if (mode == M_RES) {
#pragma unroll
            for (int ai = 0; ai < 2; ++ai) {
                f32x4 rf[4][2][2]; u32x4 rb[4][2];
#pragma unroll
                for (int m = 0; m < 4; ++m) { const int row = rowb + ai * HALF + m * 16;
#pragma unroll
                    for (int bj = 0; bj < 2; ++bj) { const int col = u.pn * BM + bj * HALF + cw;
                        if (reskind == 0) { const float* p = (row < NPROMPT ? x0 + (size_t)row * 1024 : x1 + (size_t)(row - NPROMPT) * 1024) + col; rf[m][bj][0] = *(const f32x4*)p; rf[m][bj][1] = *(const f32x4*)(p + 4); }
                        else if (reskind == 1) rb[m][bj] = *(const u32x4*)(b0 + (size_t)row * 1024 + col);
                        else { const float* p = f32buf + (size_t)row * 1024 + col; rf[m][bj][0] = *(const f32x4*)p; rf[m][bj][1] = *(const f32x4*)(p + 4); } } }
                asm volatile("" ::: "memory");
#pragma unroll
                for (int m = 0; m < 4; ++m) { const int row = rowb + ai * HALF + m * 16; float ssq = 0.f;
#pragma unroll
                    for (int bj = 0; bj < 2; ++bj) { const int col = u.pn * BM + bj * HALF + cw; f32x4 r0, r1;
                        if (reskind == 1) unpack8(rb[m][bj], r0, r1); else { r0 = rf[m][bj][0]; r1 = rf[m][bj][1]; }
                        const f32x4 y0 = r0 + acc[ai][bj][m][0], y1 = r1 + acc[ai][bj][m][1];
                        ssq += (y0[0] * y0[0] + y0[1] * y0[1]) + (y0[2] * y0[2] + y0[3] * y0[3]) + (y1[0] * y1[0] + y1[1] * y1[1]) + (y1[2] * y1[2] + y1[3] * y1[3]);
                        if (wf32) { float* p = f32buf + (size_t)row * 1024 + col; *(f32x4*)p = y0; *(f32x4*)(p + 4) = y1; }
                        if (wbf) *(u32x4*)(b0 + (size_t)row * 1024 + col) = pack8(y0, y1); }
                    ssq += __shfl_xor(ssq, 16); ssq += __shfl_xor(ssq, 32);
                    if (fq == 0) unsafeAtomicAdd(ssout + row, ssq); }
                asm volatile("" ::: "memory"); }
        } else if (mode == M_WINA && u.pn < 3) {
            const int pn = u.pn; const bool isq = pn < 2, nrm = isq || wc < 2;
            const float* nw = isq ? qnw : knw; const float scl = isq ? 0.125f * 1.4426950408889634f : 1.0f;
            f32x4 w00 = (f32x4){1.f, 1.f, 1.f, 1.f}, w01 = w00, w10 = w00, w11 = w00;
            if (nrm) { w00 = *(const f32x4*)(nw + 8 * fq); w01 = *(const f32x4*)(nw + 8 * fq + 4); w10 = *(const f32x4*)(nw + 32 + 8 * fq); w11 = *(const f32x4*)(nw + 32 + 8 * fq + 4); }
#pragma unroll
            for (int ai = 0; ai < 2; ++ai)
#pragma unroll
                for (int m = 0; m < 4; ++m) { const int row = rowb + ai * HALF + m * 16; const float r = rsqrtf(ssin[row] * (1.0f / 1024.0f) + 1e-6f);
                    f32x4 a0 = acc[ai][0][m][0] * r, a1 = acc[ai][0][m][1] * r, b0v = acc[ai][1][m][0] * r, b1v = acc[ai][1][m][1] * r;
                    if (nrm) {
                        float ss = (a0[0] * a0[0] + a0[1] * a0[1]) + (a0[2] * a0[2] + a0[3] * a0[3]) + (a1[0] * a1[0] + a1[1] * a1[1]) + (a1[2] * a1[2] + a1[3] * a1[3])
                                 + (b0v[0] * b0v[0] + b0v[1] * b0v[1]) + (b0v[2] * b0v[2] + b0v[3] * b0v[3]) + (b1v[0] * b1v[0] + b1v[1] * b1v[1]) + (b1v[2] * b1v[2] + b1v[3] * b1v[3]);
                        ss += __shfl_xor(ss, 16); ss += __shfl_xor(ss, 32);
                        const float rinv = rsqrtf(ss * (1.0f / 64.0f) + 1e-6f);
                        const int pos = row & 2047;
                        const f32x4 c0 = *(const f32x4*)(ropec + pos * 32 + 4 * fq), s0 = *(const f32x4*)(ropes + pos * 32 + 4 * fq);
                        const f32x4 c1 = *(const f32x4*)(ropec + pos * 32 + 16 + 4 * fq), s1 = *(const f32x4*)(ropes + pos * 32 + 16 + 4 * fq);
                        a0 = a0 * rinv * w00; a1 = a1 * rinv * w01; b0v = b0v * rinv * w10; b1v = b1v * rinv * w11;
                        const f32x4 ra0 = (f32x4){a0[0] * c0[0] - a0[1] * s0[0], a0[0] * s0[0] + a0[1] * c0[0], a0[2] * c0[1] - a0[3] * s0[1], a0[2] * s0[1] + a0[3] * c0[1]} * scl;
                        const f32x4 ra1 = (f32x4){a1[0] * c0[2] - a1[1] * s0[2], a1[0] * s0[2] + a1[1] * c0[2], a1[2] * c0[3] - a1[3] * s0[3], a1[2] * s0[3] + a1[3] * c0[3]} * scl;
                        const f32x4 rb0 = (f32x4){b0v[0] * c1[0] - b0v[1] * s1[0], b0v[0] * s1[0] + b0v[1] * c1[0], b0v[2] * c1[1] - b0v[3] * s1[1], b0v[2] * s1[1] + b0v[3] * c1[1]} * scl;
                        const f32x4 rb1 = (f32x4){b1v[0] * c1[2] - b1v[1] * s1[2], b1v[0] * s1[2] + b1v[1] * c1[2], b1v[2] * c1[3] - b1v[3] * s1[3], b1v[2] * s1[3] + b1v[3] * c1[3]} * scl;
                        bf16_t* dp = isq ? q + (size_t)row * 512 + (pn * 4 + wc) * 64 + 8 * fq : kv + (size_t)row * 256 + wc * 64 + 8 * fq;
                        *(u32x4*)dp = pack8(ra0, ra1); *(u32x4*)(dp + 32) = pack8(rb0, rb1);
                    } else {
                        bf16_t* dp = kv + (size_t)row * 256 + 128 + (wc - 2) * 32 + 8 * fq;
                        *(u32x4*)dp = pack8(a0, a1); *(u32x4*)(dp + 64) = pack8(b0v, b1v);
                    } }
        } else if (mode == M_WINA) {
            bf16_t* dst; int ld, cofs, kind = 0; const int pn = u.pn;
            if (pn < 2) { dst = q; ld = 512; cofs = pn * 256; }
            else if (pn == 2) { dst = kv; ld = 256; cofs = 0; }
            else if (pn < 5) { dst = mqk; ld = 0; cofs = (pn - 3) * 256; kind = 3; }
            else if (pn == 5) { dst = mqk; ld = 0; cofs = 0; kind = 2; }
            else if (pn < 8) { dst = opre; ld = 512; cofs = (pn - 6) * 256; kind = 1; }
            else { dst = mqk + (size_t)TOK * 512; ld = 1; cofs = (pn - 8) * 256; kind = 3; }
#pragma unroll
            for (int ai = 0; ai < 2; ++ai)
#pragma unroll
                for (int m = 0; m < 4; ++m) { const int row = rowb + ai * HALF + m * 16; const float r = rsqrtf(ssin[row] * (1.0f / 1024.0f) + 1e-6f);
#pragma unroll
                    for (int bj = 0; bj < 2; ++bj) { f32x4 v0 = acc[ai][bj][m][0] * r, v1 = acc[ai][bj][m][1] * r;
                        if (kind == 2) { if (bj == 0 && wc == 0 && fq < 2) { float* gp = g16 + (size_t)row * 16 + 8 * fq; *(f32x4*)gp = v0; *(f32x4*)(gp + 4) = v1; } }
                        else if (kind == 3) {
                            const int c0 = cofs + bj * HALF + cw, hd = c0 >> 7, d0 = c0 & 127, ks = d0 >> 4, hh = (d0 >> 3) & 1;
                            const int bb = row >> 11, t = row & 2047, chunk = t >> 6, ti = (t >> 5) & 1; int r = t & 31; if (ld) r = sigma32e(r);
                            const size_t off = ((((size_t)((bb * 4 + hd) * 32 + chunk) * 2 + ti) * 8 + ks) * 64 + hh * 32 + r) * 8;
                            *(u32x4*)(dst + off) = pack8(v0, v1); }
                        else { if (kind == 1) {
#pragma unroll
                                for (int i = 0; i < 4; ++i) { v0[i] = sigm(v0[i]); v1[i] = sigm(v1[i]); } }
                            *(u32x4*)(dst + (size_t)row * ld + cofs + bj * HALF + cw) = pack8(v0, v1); } } }
        } else if (mode == M_KVT) {
            f32x4 rc[2][2];
#pragma unroll
            for (int bj = 0; bj < 2; ++bj) { const float* sp = ssin + u.pn * BM + bj * HALF + cw;
#pragma unroll
                for (int n = 0; n < 2; ++n) { const f32x4 s = *(const f32x4*)(sp + 4 * n);
#pragma unroll
                    for (int i = 0; i < 4; ++i) rc[bj][n][i] = rsqrtf(s[i] * (1.0f / 1024.0f) + 1e-6f); } }
#pragma unroll
            for (int ai = 0; ai < 2; ++ai)
#pragma unroll
                for (int m = 0; m < 4; ++m) { const int row = rowb + ai * HALF + m * 16;
#pragma unroll
                    for (int bj = 0; bj < 2; ++bj) {
                        const int isv = row >> 9, nn = row & 511, hd = nn >> 7, d = nn & 127, m0 = u.pn * BM + bj * HALF + cw;
                        const int bb = m0 >> 11, s = m0 & 2047, chunk = s >> 6, k = (s >> 4) & 3, hh = (s >> 3) & 1;
                        const int l64 = hh * 32 + (isv ? (d & 31) : sigma32e(d & 31));
                        const size_t off = (((((size_t)(bb * 4 + hd) * 32 + chunk) * 4 + (d >> 5)) * 4 + k) * 64 + l64) * 8;
                        *(u32x4*)(b0 + (size_t)isv * TOK * 512 + off) = pack8(acc[ai][bj][m][0] * rc[bj][0], acc[ai][bj][m][1] * rc[bj][1]); } }
        } else if (mode == M_GAGM) {
#pragma unroll
            for (int ai = 0; ai < 2; ++ai)
#pragma unroll
                for (int m = 0; m < 4; ++m) { const int row = rowb + ai * HALF + m * 16; const float r = rsqrtf(ssin[row] * (1.0f / 1024.0f) + 1e-6f);
#pragma unroll
                    for (int bj = 0; bj < 2; ++bj) { f32x4 v0 = acc[ai][bj][m][0] * r, v1 = acc[ai][bj][m][1] * r;
#pragma unroll
                        for (int i = 0; i < 4; ++i) { v0[i] = sigm(v0[i]); v1[i] = sigm(v1[i]); }
                        bf16_t* gd = (u.pn < 4) ? b0 + (size_t)row * 1024 + u.pn * BM : (bf16_t*)gate + (size_t)row * 1024 + (u.pn - 4) * BM;
                        *(u32x4*)(gd + bj * HALF + cw) = pack8(v0, v1); } }
        } else if (mode == M_UPF) {
            const int rowb = (u.pm - TOK / BM) * BM + wr * 64 + fr; const int pn0 = u.pn - 4;
#pragma unroll
            for (int ai = 0; ai < 2; ++ai) {
                u32x4 gm[4][2];
#pragma unroll
                for (int m = 0; m < 4; ++m) { const int row = rowb + ai * HALF + m * 16;
#pragma unroll
                    for (int bj = 0; bj < 2; ++bj) gm[m][bj] = *(const u32x4*)(gate + (size_t)row * 1024 + pn0 * BM + bj * HALF + cw); }
                asm volatile("" ::: "memory");
#pragma unroll
                for (int m = 0; m < 4; ++m) { const int row = rowb + ai * HALF + m * 16;
#pragma unroll
                    for (int bj = 0; bj < 2; ++bj) { f32x4 m0, m1; unpack8(gm[m][bj], m0, m1);
                        *(u32x4*)(b0 + (size_t)row * 1024 + pn0 * BM + bj * HALF + cw) = pack8(m0 * acc[ai][bj][m][0], m1 * acc[ai][bj][m][1]); } }
                asm volatile("" ::: "memory"); }
        } else {
#pragma unroll
            for (int ai = 0; ai < 2; ++ai) {
                u32x4 gw[4][2], pw[4][2];
#pragma unroll
                for (int m = 0; m < 4; ++m) { const int row = rowb + ai * HALF + m * 16;
#pragma unroll
                    for (int bj = 0; bj < 2; ++bj) { const int col = u.pn * BM + bj * HALF + cw; gw[m][bj] = *(const u32x4*)(gate + (size_t)row * 2048 + col);
                        if (mode == M_UPM) pw[m][bj] = *(const u32x4*)(b0 + (size_t)row * 1024 + col); } }
                asm volatile("" ::: "memory");
#pragma unroll
                for (int m = 0; m < 4; ++m) { const int row = rowb + ai * HALF + m * 16;
#pragma unroll
                    for (int bj = 0; bj < 2; ++bj) { const int col = u.pn * BM + bj * HALF + cw; f32x4 g0, g1; unpack8(gw[m][bj], g0, g1);
                        f32x4 y0 = g0 * acc[ai][bj][m][0], y1 = g1 * acc[ai][bj][m][1];
                        if (mode == M_UPM) { f32x4 p0, p1; unpack8(pw[m][bj], p0, p1); y0 += p0; y1 += p1; }
                        *(u32x4*)(b0 + (size_t)row * 1024 + col) = pack8(y0, y1); } }
                asm volatile("" ::: "memory"); }
        }
    }
};
template <class Epi, class Sched, bool ALIGN_EPI = false, bool SP2 = false>
__device__ __forceinline__ void gemm_phase(PG8_LAS unsigned char* lds, const Gemm g, const Sched& S, const Epi& E) {
    int tid_l = threadIdx.x; asm volatile("" : "+v"(tid_l)); const int tid = tid_l, wid = __builtin_amdgcn_readfirstlane(tid >> 6), lane = tid & 63, wr = wid >> 2, wc = wid & 3, fr = lane & 15, fq = lane >> 4;
    const int K = g.K, nt = K / BK;
    unsigned voffA[2], voffB[2];
#pragma unroll
    for (int i = 0; i < 2; ++i) { int R, C; stage_rc(tid * 16 + i * 8192, R, C); const int Rb = Epi::PERM ? ((R & ~31) + perm32(R & 31)) : R;
        voffA[i] = (unsigned)(R * K + C) * 2u; voffB[i] = (unsigned)(Rb * K + C) * 2u; }
    const size_t kstep = (size_t)(BK * 2);
    const size_t hstep = (size_t)HALF * K * 2;
    const size_t tstep = 2 * hstep;
    const unsigned ldsw = (unsigned)wid * 1024u;
    const int aoff = lds_byte(wr * 64 + fr, fq * 8), boff = lds_byte(wc * 32 + fr, fq * 8);
#define PG8_SA(b, h) (((b) * 2 + (h)) * HTB)
#define PG8_SB(b, h) ((4 + (b) * 2 + (h)) * HTB)
#define PG8_STAGE(bufoff, gbase, voff) do { _Pragma("unroll") for (int _i = 0; _i < 2; ++_i) \
        __builtin_amdgcn_global_load_lds((const unsigned*)((const char*)(gbase) + (voff)[_i]), (PG8_LAS unsigned*)(lds + (bufoff) + ldsw + _i * 8192), 16, 0, 0); } while (0)
#define PG8_LDA(dst, b, h) do { _Pragma("unroll") for (int m = 0; m < 4; ++m) _Pragma("unroll") for (int k = 0; k < 2; ++k) dst[m][k] = *(const PG8_LAS bf16x8*)(lds + PG8_SA(b, h) + aoff + m * 2048 + k * 1024); } while (0)
#define PG8_LDB(dst, b, h) do { _Pragma("unroll") for (int n = 0; n < 2; ++n) _Pragma("unroll") for (int k = 0; k < 2; ++k) dst[n][k] = *(const PG8_LAS bf16x8*)(lds + PG8_SB(b, h) + boff + n * 2048 + k * 1024); } while (0)
#define PG8_MMA(ai, bj, At, Bt) do { __builtin_amdgcn_s_setprio(1); _Pragma("unroll") for (int m = 0; m < 4; ++m) _Pragma("unroll") for (int n = 0; n < 2; ++n) _Pragma("unroll") for (int k = 0; k < 2; ++k) \
        acc[ai][bj][m][n] = __builtin_amdgcn_mfma_f32_16x16x32_bf16(Bt[n][k], At[m][k], acc[ai][bj][m][n], 0, 0, 0); __builtin_amdgcn_s_setprio(0); } while (0)
#define PG8_WAIT_V(n) asm volatile("s_waitcnt vmcnt(" #n ")" ::: "memory")
#define PG8_WAIT_L(n) asm volatile("s_waitcnt lgkmcnt(" #n ")" ::: "memory")
#define PG8_BAR __builtin_amdgcn_s_barrier()
#define PG8_SCHED __builtin_amdgcn_sched_barrier(0)
    Unit cur, nxt; int ui = 0;
    if (!S.next(0, cur)) return;
    f32x4 acc[2][2][4][2];
#pragma unroll
    for (int a = 0; a < 2; ++a)
#pragma unroll
        for (int b = 0; b < 2; ++b)
#pragma unroll
            for (int m = 0; m < 4; ++m)
#pragma unroll
                for (int n = 0; n < 2; ++n) acc[a][b][m][n] = (f32x4){0.f, 0.f, 0.f, 0.f};
    bf16x8 At[4][2], B0[2][2], B1[2][2];
    const char* cA = (const char*)g.A + (size_t)cur.pm * tstep; const char* cB = (const char*)g.Bt + (size_t)cur.pn * tstep;
    S.a_ready(cur);
    if constexpr (SP2) {
        PG8_STAGE(PG8_SB(0, 0), cB, voffB); PG8_STAGE(PG8_SB(0, 1), cB + hstep, voffB); PG8_STAGE(PG8_SA(0, 0), cA, voffA); PG8_STAGE(PG8_SA(0, 1), cA + hstep, voffA);
        if (wr == 1) PG8_BAR;
        PG8_WAIT_V(2); PG8_BAR;
        PG8_STAGE(PG8_SB(1, 0), cB + kstep, voffB); PG8_STAGE(PG8_SA(1, 0), cA + kstep, voffA); PG8_STAGE(PG8_SB(1, 1), cB + hstep + kstep, voffB);
        PG8_WAIT_V(6); PG8_BAR;
    } else {
        PG8_STAGE(PG8_SB(0, 0), cB, voffB); PG8_STAGE(PG8_SA(0, 0), cA, voffA); PG8_STAGE(PG8_SB(0, 1), cB + hstep, voffB); PG8_STAGE(PG8_SA(0, 1), cA + hstep, voffA);
        if (wr == 1) PG8_BAR;
        PG8_WAIT_V(4); PG8_BAR;
        PG8_STAGE(PG8_SB(1, 0), cB + kstep, voffB); PG8_STAGE(PG8_SA(1, 0), cA + kstep, voffA); PG8_STAGE(PG8_SB(1, 1), cB + hstep + kstep, voffB);
        PG8_WAIT_V(6); PG8_BAR;
    }
    for (;;) {
        const bool has_next = S.next(ui + 1, nxt);
        const char* nA = has_next ? (const char*)g.A + (size_t)nxt.pm * tstep : cA; const char* nB = has_next ? (const char*)g.Bt + (size_t)nxt.pn * tstep : cB;
        for (int t = 0; t < nt; t += 2) {
            const bool last = (t == nt - 2);
            const char* a1 = cA + (size_t)(t + 1) * kstep;
            const char* a2 = last ? nA : cA + (size_t)(t + 2) * kstep; const char* b2 = last ? nB : cB + (size_t)(t + 2) * kstep;
            const char* a3 = a2 + kstep; const char* b3 = b2 + kstep;
            if (last && has_next) S.a_ready(nxt);
            if constexpr (SP2) {
            PG8_LDB(B0, 0, 0); PG8_LDB(B1, 0, 1); PG8_SCHED; PG8_LDA(At, 0, 0); PG8_STAGE(PG8_SA(1, 1), a1 + hstep, voffA);
            PG8_WAIT_V(8); PG8_WAIT_L(0); PG8_BAR; PG8_MMA(0, 0, At, B0); PG8_MMA(0, 1, At, B1); PG8_BAR; PG8_SCHED;
            PG8_LDA(At, 0, 1); PG8_STAGE(PG8_SB(0, 0), b2, voffB); PG8_STAGE(PG8_SB(0, 1), b2 + hstep, voffB); PG8_STAGE(PG8_SA(0, 0), a2, voffA);
            PG8_WAIT_V(8); PG8_WAIT_L(0); PG8_BAR; PG8_MMA(1, 0, At, B0); PG8_MMA(1, 1, At, B1); PG8_BAR; PG8_SCHED;
            PG8_LDB(B0, 1, 0); PG8_LDB(B1, 1, 1); PG8_SCHED; PG8_LDA(At, 1, 0); PG8_STAGE(PG8_SA(0, 1), a2 + hstep, voffA);
            PG8_WAIT_V(8); PG8_WAIT_L(0); PG8_BAR; PG8_MMA(0, 0, At, B0); PG8_MMA(0, 1, At, B1); PG8_BAR; PG8_SCHED;
            PG8_LDA(At, 1, 1); PG8_STAGE(PG8_SB(1, 0), b3, voffB); PG8_STAGE(PG8_SB(1, 1), b3 + hstep, voffB); PG8_STAGE(PG8_SA(1, 0), a3, voffA);
            PG8_WAIT_V(8); PG8_WAIT_L(0); PG8_BAR; PG8_MMA(1, 0, At, B0); PG8_MMA(1, 1, At, B1); PG8_BAR; PG8_SCHED;
            } else {
            PG8_LDB(B0, 0, 0); PG8_SCHED; PG8_LDA(At, 0, 0); PG8_STAGE(PG8_SA(1, 1), a1 + hstep, voffA);
            PG8_WAIT_L(8); PG8_BAR; PG8_WAIT_L(0); PG8_MMA(0, 0, At, B0); PG8_BAR; PG8_SCHED;
            PG8_LDB(B1, 0, 1); PG8_STAGE(PG8_SB(0, 0), b2, voffB);
            PG8_BAR; PG8_WAIT_L(0); PG8_MMA(0, 1, At, B1); PG8_BAR;
            PG8_LDA(At, 0, 1); PG8_STAGE(PG8_SA(0, 0), a2, voffA);
            PG8_BAR; PG8_WAIT_L(0); PG8_MMA(1, 0, At, B0); PG8_BAR; PG8_SCHED;
            PG8_STAGE(PG8_SB(0, 1), b2 + hstep, voffB);
            PG8_WAIT_V(6); PG8_BAR; PG8_MMA(1, 1, At, B1); PG8_BAR;
            PG8_LDB(B0, 1, 0); PG8_SCHED; PG8_LDA(At, 1, 0); PG8_STAGE(PG8_SA(0, 1), a2 + hstep, voffA);
            PG8_WAIT_L(8); PG8_BAR; PG8_WAIT_L(0); PG8_MMA(0, 0, At, B0); PG8_BAR; PG8_SCHED;
            PG8_LDB(B1, 1, 1); PG8_STAGE(PG8_SB(1, 0), b3, voffB);
            PG8_BAR; PG8_WAIT_L(0); PG8_MMA(0, 1, At, B1); PG8_BAR;
            PG8_LDA(At, 1, 1); PG8_STAGE(PG8_SA(1, 0), a3, voffA);
            PG8_BAR; PG8_WAIT_L(0); PG8_MMA(1, 0, At, B0); PG8_BAR; PG8_SCHED;
            PG8_STAGE(PG8_SB(1, 1), b3 + hstep, voffB);
            PG8_WAIT_V(6); PG8_BAR; PG8_MMA(1, 1, At, B1); PG8_BAR;
            }
        }
        if constexpr (ALIGN_EPI) { if (wr == 0) PG8_BAR; }
        bool keep_acc = false;
        if constexpr (Epi::HAS_MID) { if (E.is_first_half(cur)) { E.mid(acc, cur, wr, wc, fr, fq); keep_acc = true; } else E(acc, cur, wr, wc, fr, fq); }
        else if constexpr (!Epi::AFTER_DRAIN) { E(acc, cur, wr, wc, fr, fq); S.done(cur); }
        if (!has_next) break;
        if (!keep_acc)
#pragma unroll
        for (int a = 0; a < 2; ++a)
#pragma unroll
            for (int b = 0; b < 2; ++b)
#pragma unroll
                for (int m = 0; m < 4; ++m)
#pragma unroll
                    for (int n = 0; n < 2; ++n) acc[a][b][m][n] = (f32x4){0.f, 0.f, 0.f, 0.f};
        cur = nxt; cA = nA; cB = nB; ++ui;
        if constexpr (ALIGN_EPI) { if (wr == 1) PG8_BAR; }
    }
    PG8_WAIT_V(0);
    if constexpr (!ALIGN_EPI) { if (wr == 0) PG8_BAR; }
    PG8_BAR;
    if constexpr (Epi::AFTER_DRAIN) { E.fused(acc, cur, wr, wc, fr, fq, lds, wid, lane); S.done(cur); }
#undef PG8_SA
#undef PG8_SB
#undef PG8_STAGE
#undef PG8_LDA
#undef PG8_LDB
#undef PG8_MMA
#undef PG8_WAIT_V
#undef PG8_WAIT_L
#undef PG8_BAR
#undef PG8_SCHED
}
}
#include <hip/hip_bf16.h>
#include <cmath>
namespace attn_body {
using bf16=__hip_bfloat16;
using bf16x8=__attribute__((ext_vector_type(8)))short;
using s16x4=__attribute__((ext_vector_type(4)))short;
using f32x16=__attribute__((ext_vector_type(16)))float;
using u32x4=__attribute__((ext_vector_type(4)))unsigned;
constexpr int BATCH=24,NHEAD=8,SEQ=2048,D=64,QP=512,KVP=256,OP=512;
constexpr int NW=8,QBLK=32,QB=QBLK*NW,KVBLK=64,NQB=SEQ/QB;
constexpr int ATTN_UNIT_ROWS=QB;
__device__ __forceinline__ int crow(int r,int hi){return (r&3)+8*(r>>2)+4*hi;}
#define SBAR() __builtin_amdgcn_sched_barrier(0)
__device__ __forceinline__ void cmask(f32x16&p0,f32x16&p1,int jb,int qrel,int hi){
  const float NEG=-INFINITY; int kb=64*jb+4*hi;
  #pragma unroll
  for(int r=0;r<16;++r){int kv=kb+(r&3)+8*(r>>2); if(kv>qrel)p0[r]=NEG; if(kv+32>qrel)p1[r]=NEG;}
}

constexpr int NSLOT=3, SLOTB=8192;
constexpr int LDS_K=0, LDS_V=NSLOT*SLOTB, LDS_WS=2*NSLOT*SLOTB, LDS_OST=LDS_WS+NW*64*4, LDS_BYTES=LDS_OST+NW*4096;
constexpr float C2=0.125f*1.4426950408889634f;
__device__ __forceinline__ void glds16(const void*gsrc,unsigned lds_dst){unsigned keep;
  asm volatile("s_mov_b32 %0, m0\n\ts_mov_b32 m0, %2\n\ts_nop 0\n\tglobal_load_lds_dwordx4 %1, off\n\ts_mov_b32 m0, %0":"=&s"(keep):"v"(gsrc),"s"(lds_dst):"memory");}
__device__ __forceinline__ float max3f(float a,float b,float c){float r;asm("v_max3_f32 %0, %1, %2, %3":"=v"(r):"v"(a),"v"(b),"v"(c));return r;}
__device__ __forceinline__ float max2f(float a,float b){float r;asm("v_max_f32_e32 %0, %1, %2":"=v"(r):"v"(a),"v"(b));return r;}
__device__ __forceinline__ float fadd_s(float a,float b){float r;asm("v_add_f32_e32 %0, %1, %2":"=v"(r):"v"(a),"v"(b));return r;}
__device__ __forceinline__ float fsub_s(float a,float b){float r;asm("v_sub_f32_e32 %0, %1, %2":"=v"(r):"v"(a),"v"(b));return r;}
typedef float f32x2_t __attribute__((ext_vector_type(2))); typedef __bf16 bf16x2_t __attribute__((ext_vector_type(2)));
__device__ __forceinline__ unsigned cvtpk_s(float lo,float hi){f32x2_t v={lo,hi};bf16x2_t b=__builtin_convertvector(v,bf16x2_t);return __builtin_bit_cast(unsigned,b);}
#define WAIT_BAR(N) asm volatile("s_waitcnt vmcnt(" #N ") lgkmcnt(0)\n\ts_barrier":::"memory")

__device__ __forceinline__ void qkt(f32x16&p0,f32x16&p1,const char*Kslot,const bf16x8*qr,const f32x16&negm,int r32,int hi){
  const char*kb=Kslot+hi*1024+r32*16;
  #pragma unroll
  for(int d0=0;d0<4;++d0){
    const bf16x8 b0=*reinterpret_cast<const bf16x8*>(kb+d0*2048);
    const bf16x8 b1=*reinterpret_cast<const bf16x8*>(kb+d0*2048+512);
    if(d0==0){p0=__builtin_amdgcn_mfma_f32_32x32x16_bf16(b0,qr[0],negm,0,0,0);p1=__builtin_amdgcn_mfma_f32_32x32x16_bf16(b1,qr[0],negm,0,0,0);}
    else{p0=__builtin_amdgcn_mfma_f32_32x32x16_bf16(b0,qr[d0],p0,0,0,0);p1=__builtin_amdgcn_mfma_f32_32x32x16_bf16(b1,qr[d0],p1,0,0,0);}}
}
typedef __attribute__((address_space(3))) const char* lds_cptr;
typedef short v4i16_t __attribute__((ext_vector_type(4)));
__device__ __forceinline__ void kload8(bf16x8*kf,lds_cptr kp){
  kf[0]=*(const __attribute__((address_space(3))) bf16x8*)(kp);      kf[1]=*(const __attribute__((address_space(3))) bf16x8*)(kp+512);
  kf[2]=*(const __attribute__((address_space(3))) bf16x8*)(kp+2048); kf[3]=*(const __attribute__((address_space(3))) bf16x8*)(kp+2560);
  kf[4]=*(const __attribute__((address_space(3))) bf16x8*)(kp+4096); kf[5]=*(const __attribute__((address_space(3))) bf16x8*)(kp+4608);
  kf[6]=*(const __attribute__((address_space(3))) bf16x8*)(kp+6144); kf[7]=*(const __attribute__((address_space(3))) bf16x8*)(kp+6656);
}
__device__ __forceinline__ void kload2(bf16x8*kf,lds_cptr kp,int j){ kf[2*j]=*(const __attribute__((address_space(3))) bf16x8*)(kp+j*2048); kf[2*j+1]=*(const __attribute__((address_space(3))) bf16x8*)(kp+j*2048+512); }
__device__ __forceinline__ s16x4 vtr(lds_cptr p){ return __builtin_bit_cast(s16x4,__builtin_amdgcn_ds_read_tr16_b64_v4i16((__attribute__((address_space(3))) v4i16_t*)p)); }
__device__ __forceinline__ float rowmax(const f32x16&p0,const f32x16&p1){
  float a=max3f(p0[0],p0[1],p1[0]),b=max3f(p0[2],p0[3],p1[1]);a=max3f(a,p1[2],p1[3]);
  #pragma unroll
  for(int r=4;r<16;r+=4){a=max3f(a,p0[r],p0[r+1]);b=max3f(b,p0[r+2],p0[r+3]);a=max3f(a,p1[r],p1[r+1]);b=max3f(b,p1[r+2],p1[r+3]);}
  const float m=max2f(a,b);
  auto rr=__builtin_amdgcn_permlane32_swap(__float_as_uint(m),__float_as_uint(m),false,false);
  return max2f(__uint_as_float(rr[0]),__uint_as_float(rr[1]));
}
__device__ __forceinline__ void pv(f32x16*o,int vb,bf16x8 pa0,bf16x8 pa1,bf16x8 pa2,bf16x8 pa3){
  #pragma unroll
  for(int d0=0;d0<2;++d0){s16x4 lo[4],hi[4];
    #pragma unroll
    for(int ks=0;ks<4;++ks){
      asm volatile("ds_read_b64_tr_b16 %0,%1 offset:%c2":"=&v"(lo[ks]):"v"(vb),"i"(d0*4096+ks*1024):"memory");
      asm volatile("ds_read_b64_tr_b16 %0,%1 offset:%c2":"=&v"(hi[ks]):"v"(vb),"i"(d0*4096+ks*1024+512):"memory");}
    asm volatile("s_waitcnt lgkmcnt(0)":::"memory");SBAR();
    #define PK(k) (bf16x8){lo[k][0],lo[k][1],lo[k][2],lo[k][3],hi[k][0],hi[k][1],hi[k][2],hi[k][3]}
    o[d0]=__builtin_amdgcn_mfma_f32_32x32x16_bf16(pa0,PK(0),o[d0],0,0,0);
    o[d0]=__builtin_amdgcn_mfma_f32_32x32x16_bf16(pa1,PK(1),o[d0],0,0,0);
    o[d0]=__builtin_amdgcn_mfma_f32_32x32x16_bf16(pa2,PK(2),o[d0],0,0,0);
    o[d0]=__builtin_amdgcn_mfma_f32_32x32x16_bf16(pa3,PK(3),o[d0],0,0,0);
    #undef PK
  }
}

#ifndef ATTN_STORE16
#define ATTN_STORE16(p,v) (*(u32x4*)(p)=(v))
#endif
template<int THRL> __device__ __forceinline__ void attn_unit(int b,int h,int qb,const bf16*Q,const bf16*__restrict__ K,const bf16*__restrict__ V,bf16*O,char*shm){
  int tid_l=threadIdx.x; asm volatile("":"+v"(tid_l)); const int tid=tid_l,lane=tid&63,r32=lane&31,hi=lane>>5; const int wid=__builtin_amdgcn_readfirstlane(tid>>6);
  const long rowbase=(long)b*SEQ; const int q0=qb*QB;
  const bf16*Qw=Q+(rowbase+q0+wid*QBLK)*QP+h*D;
  const bf16*Kh=K+rowbase*KVP+(h>>2)*D,*Vh=V+rowbase*KVP+(h>>2)*D;
  const unsigned lds0=(unsigned)(uintptr_t)shm;
  float*wsf=(float*)(shm+LDS_WS)+wid*64;
  const bf16*ksrc=Kh+(long)lane*KVP+wid*8;
  const bf16*vsrc=Vh+(long)(16*(wid&3)+(lane>>2))*KVP+(wid>>2)*32+(lane&3)*8;
  const unsigned kdst=lds0+LDS_K+wid*1024, vdst=lds0+LDS_V+wid*1024;
  #define DMA_K(t,slot) glds16(ksrc+(long)(t)*KVBLK*KVP,(unsigned)__builtin_amdgcn_readfirstlane(kdst+(slot)))
  #define DMA_V(t,slot) glds16(vsrc+(long)(t)*KVBLK*KVP,(unsigned)__builtin_amdgcn_readfirstlane(vdst+(slot)))
  const int vb0=(int)(lds0+LDS_V)+((lane>>4)&1)*32+(lane&3)*8+(4*hi+((lane&15)>>2))*64;
  const char*Kbase=shm+LDS_K; bf16x8 kf[8];
  const lds_cptr shm3=(lds_cptr)shm; const lds_cptr kp0=shm3+LDS_K+hi*1024+r32*16; const lds_cptr vp0=shm3+LDS_V+((lane>>4)&1)*32+(lane&3)*8+(4*hi+((lane&15)>>2))*64;
  const int NT=SEQ/KVBLK;
  DMA_K(0,0);DMA_V(0,0);DMA_K(1,SLOTB);
  bf16x8 qr[4];
  #pragma unroll
  for(int d0=0;d0<4;++d0)qr[d0]=*reinterpret_cast<const bf16x8*>(&Qw[(long)r32*QP+d0*16+hi*8]);
  float mhat=0.f,l_reg=0.f;f32x16 o[2];o[0]=f32x16{};o[1]=f32x16{};f32x16 negm=f32x16{};asm volatile("":"+v"(negm));
  const int qrel=wid*QBLK+r32;
  #define CMASK(P0,P1,t) do{}while(0)
  bool resc=false;
  #define START(P0,P1) do{ const float rm=rowmax(P0,P1); resc=false; \
    { const float dl=rm; mhat=fadd_s(mhat,dl); \
      _Pragma("unroll") for(int r=0;r<16;++r){P0[r]=fsub_s(P0[r],dl);P1[r]=fsub_s(P1[r],dl);} \
      _Pragma("unroll") for(int r=0;r<16;++r)negm[r]=-mhat; asm volatile("":"+v"(negm)); } \
    _Pragma("unroll") for(int r=0;r<16;++r)P0[r]=__builtin_amdgcn_exp2f(P0[r]); }while(0)
  #define RESC() do{ if(resc){ asm volatile("s_waitcnt lgkmcnt(0)":::"memory"); \
      _Pragma("unroll") for(int d_=0;d_<2;++d_) _Pragma("unroll") for(int r=0;r<16;++r)o[d_][r]*=wsf[crow(r,hi)]; } }while(0)
  f32x16 pA0,pA1,pB0,pB1;
  int sl_prev=0,sl_cur=0,sl_next=SLOTB;
  #define ROT() do{sl_prev=sl_cur;sl_cur=sl_next;sl_next=(sl_next==(NSLOT-1)*SLOTB)?0:sl_next+SLOTB;}while(0)
  DMA_K(2,2*SLOTB);
  WAIT_BAR(3);
  qkt(pA0,pA1,Kbase,qr,negm,r32,hi);asm volatile("s_nop 15\n\ts_nop 7":"+v"(pA0),"+v"(pA1));CMASK(pA0,pA1,0);
  START(pA0,pA1);
  _Pragma("unroll") for(int r=0;r<16;++r)pA1[r]=__builtin_amdgcn_exp2f(pA1[r]);
  WAIT_BAR(0);
  DMA_K(3,0);DMA_V(1,SLOTB);
  ROT();
  kload8(kf,kp0+sl_cur);
  WAIT_BAR(2);
  s16x4 vlo[8],vhi[8]; u32x4 pw0,pw1,pw2,pw3;
  #define PKW(P,B) cvtpk_s(P[B],P[B+1])
  #define PAF(k) __builtin_bit_cast(bf16x8,pw##k)
  #define VFR(i) (bf16x8){vlo[i][0],vlo[i][1],vlo[i][2],vlo[i][3],vhi[i][0],vhi[i][1],vhi[i][2],vhi[i][3]}
  #define PIN(x) asm volatile("":"+v"(x))
  #define MX3(a,b,c) __builtin_fmaxf(__builtin_fmaxf((a),(b)),(c))
  #define GAPA(MF,A0,A1,A2,A3,W0,W1,PW) do{ MF; sacc+=A0; sacc+=A1; sacc+=A2; sacc+=A3; PIN(sacc); W0; W1; PIN(PW); SBAR(); }while(0)
  #define EX(v) __builtin_amdgcn_exp2f(v)
  #define GAPB(MF,X,B) do{ MF; X[B]=EX(X[B]); X[B+1]=EX(X[B+1]); X[B+2]=EX(X[B+2]); X[B+3]=EX(X[B+3]); PIN(X); SBAR(); }while(0)
  #define VRD(i) do{ vlo[i]=vtr(vp_+(((i)>>2)*4096+((i)&3)*1024)); vhi[i]=vtr(vp_+(((i)>>2)*4096+((i)&3)*1024+512)); }while(0)
  #define KRD(G,j) do{ if(G){ kload2(kf,kp0+sl_next,j); SBAR(); } }while(0)
  #define STEP(C0,C1,P0,P1,t,GK,GV,GL) do{ SBAR(); \
    const lds_cptr vp_=vp0+sl_prev; \
    VRD(0); SBAR(); float sacc=(P0[0]+P0[1]); \
    GAPA(C0=__builtin_amdgcn_mfma_f32_32x32x16_bf16(kf[0],qr[0],negm,0,0,0), P0[2],P0[3],P0[4],P0[5],     pw0[0]=PKW(P0,0), pw0[1]=PKW(P0,2), pw0); \
    VRD(4); SBAR(); GAPA(C1=__builtin_amdgcn_mfma_f32_32x32x16_bf16(kf[1],qr[0],negm,0,0,0), P0[6],P0[7],P0[8],P0[9],     pw0[2]=PKW(P0,4), pw0[3]=PKW(P0,6), pw0); \
    VRD(1); SBAR(); GAPA(C0=__builtin_amdgcn_mfma_f32_32x32x16_bf16(kf[2],qr[1],C0,0,0,0),   P0[10],P0[11],P0[12],P0[13], pw1[0]=PKW(P0,8), pw1[1]=PKW(P0,10), pw1); \
    VRD(5); SBAR(); GAPA(C1=__builtin_amdgcn_mfma_f32_32x32x16_bf16(kf[3],qr[1],C1,0,0,0),   P0[14],P0[15],P1[0],P1[1],   pw1[2]=PKW(P0,12),pw1[3]=PKW(P0,14), pw1); \
    VRD(2); SBAR(); GAPA(C0=__builtin_amdgcn_mfma_f32_32x32x16_bf16(kf[4],qr[2],C0,0,0,0),   P1[2],P1[3],P1[4],P1[5],     pw2[0]=PKW(P1,0), pw2[1]=PKW(P1,2), pw2); \
    VRD(6); SBAR(); GAPA(C1=__builtin_amdgcn_mfma_f32_32x32x16_bf16(kf[5],qr[2],C1,0,0,0),   P1[6],P1[7],P1[8],P1[9],     pw2[2]=PKW(P1,4), pw2[3]=PKW(P1,6), pw2); \
    VRD(3); SBAR(); GAPA(C0=__builtin_amdgcn_mfma_f32_32x32x16_bf16(kf[6],qr[3],C0,0,0,0),   P1[10],P1[11],P1[12],P1[13], pw3[0]=PKW(P1,8), pw3[1]=PKW(P1,10), pw3); \
    VRD(7); SBAR(); GAPA(C1=__builtin_amdgcn_mfma_f32_32x32x16_bf16(kf[7],qr[3],C1,0,0,0),   P1[14],P1[15],0.f,0.f,       pw3[2]=PKW(P1,12),pw3[3]=PKW(P1,14), pw3); \
    l_reg+=sacc; \
    if(GK){DMA_K((t)+3,sl_cur);} if(GV){DMA_V((t)+1,sl_next);} \
    CMASK(C0,C1,t); \
    { float a=MX3(C0[0],C0[1],C1[0]),b=MX3(C0[2],C0[3],C1[1]); a=MX3(a,C1[2],C1[3]); \
      _Pragma("unroll") for(int r=4;r<16;r+=4){a=MX3(a,C0[r],C0[r+1]);b=MX3(b,C0[r+2],C0[r+3]);a=MX3(a,C1[r],C1[r+1]);b=MX3(b,C1[r+2],C1[r+3]);} \
      float rm=__builtin_fmaxf(a,b); { auto rr=__builtin_amdgcn_permlane32_swap(__float_as_uint(rm),__float_as_uint(rm),false,false); rm=__builtin_fmaxf(__uint_as_float(rr[0]),__uint_as_float(rr[1])); } \
      resc=false; \
      if(__builtin_expect(__any(rm>(float)THRL),0)){ const float dl=__builtin_fmaxf(rm,0.f); mhat+=dl; \
        _Pragma("unroll") for(int r=0;r<16;++r){C0[r]-=dl;C1[r]-=dl;} \
        _Pragma("unroll") for(int r=0;r<16;++r)negm[r]=-mhat; asm volatile("":"+v"(negm)); \
        const float f=__builtin_amdgcn_exp2f(-dl); l_reg*=f; if(hi==0)wsf[r32]=f; resc=true; } } \
    SBAR(); \
    GAPB(o[0]=__builtin_amdgcn_mfma_f32_32x32x16_bf16(PAF(0),VFR(0),o[0],0,0,0), C0,0); \
    GAPB(o[1]=__builtin_amdgcn_mfma_f32_32x32x16_bf16(PAF(0),VFR(4),o[1],0,0,0), C0,4); \
    KRD(GL,0); GAPB(o[0]=__builtin_amdgcn_mfma_f32_32x32x16_bf16(PAF(1),VFR(1),o[0],0,0,0), C0,8); \
    KRD(GL,1); GAPB(o[1]=__builtin_amdgcn_mfma_f32_32x32x16_bf16(PAF(1),VFR(5),o[1],0,0,0), C0,12); \
    KRD(GL,2); GAPB(o[0]=__builtin_amdgcn_mfma_f32_32x32x16_bf16(PAF(2),VFR(2),o[0],0,0,0), C1,0); \
    KRD(GL,3); GAPB(o[1]=__builtin_amdgcn_mfma_f32_32x32x16_bf16(PAF(2),VFR(6),o[1],0,0,0), C1,4); \
    GAPB(o[0]=__builtin_amdgcn_mfma_f32_32x32x16_bf16(PAF(3),VFR(3),o[0],0,0,0), C1,8); \
    GAPB(o[1]=__builtin_amdgcn_mfma_f32_32x32x16_bf16(PAF(3),VFR(7),o[1],0,0,0), C1,12); \
    }while(0)
  int t=1;
  #undef CMASK
  #define CMASK(P0,P1,t) do{}while(0)
  for(;t+5<NT;t+=2){
    STEP(pB0,pB1,pA0,pA1,t,true,true,true);     WAIT_BAR(2); RESC(); ROT();
    STEP(pA0,pA1,pB0,pB1,t+1,true,true,true);   WAIT_BAR(2); RESC(); ROT();
  }
  #undef CMASK
  #define CMASK(P0,P1,t) do{}while(0)
  #define ENDW(tt) do{ if((tt)+3<NT){WAIT_BAR(2);} else if((tt)+2<NT){WAIT_BAR(1);} else {WAIT_BAR(0);} }while(0)
  for(;t+1<NT;t+=2){
    STEP(pB0,pB1,pA0,pA1,t,(t+3<NT),(t+1<NT),(t+1<NT));       ENDW(t);   RESC(); ROT();
    STEP(pA0,pA1,pB0,pB1,t+1,(t+4<NT),(t+2<NT),(t+2<NT));     ENDW(t+1); RESC(); ROT();
  }
  STEP(pB0,pB1,pA0,pA1,NT-1,false,false,false); RESC();
  { float sacc=pB0[0]+pB0[1]; _Pragma("unroll") for(int r=2;r<16;++r)sacc+=pB0[r]; _Pragma("unroll") for(int r=0;r<16;++r)sacc+=pB1[r]; l_reg+=sacc;
    pw0=(u32x4){PKW(pB0,0),PKW(pB0,2),PKW(pB0,4),PKW(pB0,6)};pw1=(u32x4){PKW(pB0,8),PKW(pB0,10),PKW(pB0,12),PKW(pB0,14)};pw2=(u32x4){PKW(pB1,0),PKW(pB1,2),PKW(pB1,4),PKW(pB1,6)};pw3=(u32x4){PKW(pB1,8),PKW(pB1,10),PKW(pB1,12),PKW(pB1,14)};
    SBAR(); pv(o,vb0+sl_cur,PAF(0),PAF(1),PAF(2),PAF(3)); }
  #undef PKW
  #undef PAF
  #undef VFR
  #undef PIN
  #undef MX3
  #undef GAPA
  #undef GAPB
  #undef EX
  #undef VRD
  #undef KRD
  #undef STEP
  #undef ENDW
  {auto rr=__builtin_amdgcn_permlane32_swap(__float_as_uint(l_reg),__float_as_uint(l_reg),false,false);l_reg=__uint_as_float(rr[0])+__uint_as_float(rr[1]);}
  if(hi==0)wsf[32+r32]=l_reg;asm volatile("s_waitcnt lgkmcnt(0)":::"memory");
  float rli[16];
  #pragma unroll
  for(int r=0;r<16;++r)rli[r]=__builtin_amdgcn_rcpf(wsf[32+crow(r,hi)]);
  bf16*Ow=O+(rowbase+q0+wid*QBLK)*OP+h*D;
  { bf16*stg=(bf16*)(shm+LDS_OST)+wid*2048;
    #pragma unroll
    for(int r=0;r<16;++r){const int orow=crow(r,hi);
      #pragma unroll
      for(int d0=0;d0<2;++d0)stg[orow*64+d0*32+r32]=__float2bfloat16(o[d0][r]*rli[r]);}
    asm volatile("s_waitcnt lgkmcnt(0)":::"memory");
    #pragma unroll
    for(int i=0;i<4;++i){const int row=i*8+(lane>>3),ch=lane&7; const u32x4 v=*(const u32x4*)(stg+row*64+ch*8); ATTN_STORE16(Ow+(long)row*OP+ch*8,v);} }
  asm volatile("s_waitcnt lgkmcnt(0)\n\ts_barrier":::"memory");
  #undef DMA_K
  #undef DMA_V
  #undef CMASK
  #undef START
  #undef RESC
  #undef ROT
}
constexpr int ATTN_LDS_BYTES=LDS_BYTES;
#undef SBAR
#undef WAIT_BAR
}
namespace cg = cooperative_groups;
#define GAS __attribute__((address_space(1)))
#define LAS __attribute__((address_space(3)))
typedef unsigned short bf16;
typedef unsigned v4u __attribute__((ext_vector_type(4)));
typedef unsigned v2u __attribute__((ext_vector_type(2)));
typedef float f32x4 __attribute__((ext_vector_type(4)));
typedef float f32x16 __attribute__((ext_vector_type(16)));
typedef short bf16x8 __attribute__((ext_vector_type(8)));
constexpr int NWAVES = 8;
constexpr int T = 49152, SEQ = 2048, NB = 24, DM = 1024, DFF = 2816, DIN = 4880;
constexpr float EPS = 1e-6f, LOG2E = 1.4426950408889634f;
constexpr size_t MiB = 1u << 20;
constexpr size_t WS_CTL = 0, CTL_ZERO_BYTES = 65536;
constexpr int CW_BAR = 4096;
constexpr size_t WS_ROPEC = 1 * MiB, WS_ROPES = WS_ROPEC + 256 * 1024;
constexpr size_t WS_SS0 = 1 * MiB + 512 * 1024, WS_SS1 = WS_SS0 + 256 * 1024, WS_SS2 = WS_SS1 + 256 * 1024, WS_SS3 = WS_SS2 + 256 * 1024;
constexpr size_t WS_WOLD = 2 * MiB + 512 * 1024;
constexpr size_t WS_G16 = 3 * MiB, WS_SC = 6 * MiB, WS_DEN = 14 * MiB;
constexpr size_t WS_W1GU = 16 * MiB, WS_W1D = 27 * MiB, WS_WIN = 33 * MiB, WS_WA = 43 * MiB, WS_WM = 44 * MiB, WS_WOUT = 45 * MiB, WS_W2GU = 47 * MiB, WS_W2D = 58 * MiB;
constexpr size_t WS_XB = 64 * MiB, WS_H = 160 * MiB;
constexpr size_t WS_QB = 160 * MiB, WS_KV = 208 * MiB, WS_MQK = 232 * MiB, WS_NUM = 328 * MiB, WS_OPRE = 424 * MiB, WS_MEM = 232 * MiB, WS_MERGED = 328 * MiB, WS_SCF = 472 * MiB, WS_END = 480 * MiB;
constexpr size_t OUT_AM = 96 * MiB, WS_GA = 160 * MiB;
constexpr int RING_BYTES = 131072, MISC_OFF = 140288, LDS_BYTES = 147456;
constexpr int ML_BUF = 66560;
constexpr int N_MLSTM_BLK = 192, N_ATT_UNITS = 1536;

struct Args { const float* in[20]; float* out; unsigned char* ws; };

__device__ __forceinline__ unsigned f2bf(float f) { unsigned u = __builtin_bit_cast(unsigned, f); return (u + 0x7fffu + ((u >> 16) & 1u)) >> 16; }
__device__ __forceinline__ unsigned pk2(float lo, float hi) { return f2bf(lo) | (f2bf(hi) << 16); }
__device__ __forceinline__ float bflo(unsigned w) { return __uint_as_float(w << 16); }
__device__ __forceinline__ float bfhi(unsigned w) { return __uint_as_float(w & 0xffff0000u); }
__device__ __forceinline__ float wave_sum(float v) {
#pragma unroll
    for (int o = 1; o < 64; o <<= 1) v += __shfl_xor(v, o);
    return v;
}
#define LDS_WAIT() asm volatile("s_waitcnt lgkmcnt(0)" ::: "memory")

struct Seg { const float* W; int ldw, K, c0, nc; bf16* dst; int drow0; const float* gain; float cs; int map; int ldk, koff; };
__device__ __forceinline__ int seg_items(const Seg& s) { return (s.K / 64) * ((s.nc + 31) / 32); }
__device__ __forceinline__ Seg get_seg(int i, const Args& a) {
    unsigned char* ws = a.ws; Seg s; s.gain = nullptr; s.cs = 1.f; s.map = 0; s.c0 = 0; s.drow0 = 0; s.ldk = 0; s.koff = 0;
    bf16* WIN = (bf16*)(ws + WS_WIN);
    switch (i) {
    case 0: s.W = a.in[3]; s.ldw = DFF; s.K = DM; s.nc = DFF; s.dst = (bf16*)(ws + WS_W1GU); s.gain = a.in[2]; s.map = 1; break;
    case 1: s.W = a.in[4]; s.ldw = DFF; s.K = DM; s.nc = DFF; s.dst = (bf16*)(ws + WS_W1GU); s.drow0 = 128; s.gain = a.in[2]; s.map = 1; break;
    case 2: s.W = a.in[5]; s.ldw = DM; s.K = DFF; s.nc = DM; s.dst = (bf16*)(ws + WS_W1D); s.cs = 0.5f; break;
    case 3: s.W = a.in[16]; s.ldw = DFF; s.K = DM; s.nc = DFF; s.dst = (bf16*)(ws + WS_W2GU); s.gain = a.in[15]; s.map = 1; break;
    case 4: s.W = a.in[17]; s.ldw = DFF; s.K = DM; s.nc = DFF; s.dst = (bf16*)(ws + WS_W2GU); s.drow0 = 128; s.gain = a.in[15]; s.map = 1; break;
    case 5: s.W = a.in[18]; s.ldw = DM; s.K = DFF; s.nc = DM; s.dst = (bf16*)(ws + WS_W2D); s.cs = 0.5f; break;
    case 6: s.W = a.in[7]; s.ldw = DIN; s.K = DM; s.c0 = 0; s.nc = 512; s.dst = WIN; s.drow0 = 0; s.gain = a.in[6]; s.map = 2; break;
    case 7: s.W = a.in[7]; s.ldw = DIN; s.K = DM; s.c0 = 512; s.nc = 128; s.dst = WIN; s.drow0 = 512; s.gain = a.in[6]; s.map = 3; break;
    case 8: s.W = a.in[7]; s.ldw = DIN; s.K = DM; s.c0 = 640; s.nc = 128; s.dst = WIN; s.drow0 = 512; s.gain = a.in[6]; s.map = 4; break;
    case 9: s.W = a.in[7]; s.ldw = DIN; s.K = DM; s.c0 = 768; s.nc = 512; s.dst = WIN; s.drow0 = 768; s.gain = a.in[6]; break;
    case 10: s.W = a.in[7]; s.ldw = DIN; s.K = DM; s.c0 = 2304; s.nc = 16; s.dst = WIN; s.drow0 = 1280; s.gain = a.in[6]; break;
    case 11: s.W = a.in[7]; s.ldw = DIN; s.K = DM; s.c0 = 2320; s.nc = 512; s.dst = WIN; s.drow0 = 1536; s.gain = a.in[6]; break;
    case 12: s.W = a.in[7]; s.ldw = DIN; s.K = DM; s.c0 = 1280; s.nc = 512; s.dst = WIN; s.drow0 = 2048; s.gain = a.in[6]; s.cs = 0.08838834764831845f; break;
    case 13: s.W = a.in[7]; s.ldw = DIN; s.K = DM; s.c0 = 1792; s.nc = 512; s.dst = WIN; s.drow0 = 2560; s.gain = a.in[6]; break;
    case 14: s.W = a.in[7]; s.ldw = DIN; s.K = DM; s.c0 = 2832; s.nc = 1024; s.dst = WIN; s.drow0 = 3072; s.gain = a.in[6]; break;
    case 15: s.W = a.in[7]; s.ldw = DIN; s.K = DM; s.c0 = 3856; s.nc = 1024; s.dst = WIN; s.drow0 = 4096; s.gain = a.in[6]; break;
    case 16: s.W = a.in[12]; s.ldw = DM; s.K = 512; s.nc = DM; s.dst = (bf16*)(ws + WS_WA); break;
    case 17: s.W = a.in[13]; s.ldw = DM; s.K = 512; s.nc = DM; s.dst = (bf16*)(ws + WS_WM); break;
    default: s.W = a.in[14]; s.ldw = DM; s.K = DM; s.nc = DM; s.dst = (bf16*)(ws + WS_WOUT); break;
    }
    if (s.ldk == 0) s.ldk = s.K;
    return s;
}
constexpr int NSEG = 19;
__device__ __forceinline__ void tr_item(const Seg& s, int item, LAS float* scr, int lane) {
    const int nblk = (s.nc + 31) / 32, kb = item / nblk, nb = item % nblk, k0 = 64 * kb, cb = 32 * nb;
    const int nv = (s.nc - cb) < 32 ? (s.nc - cb) : 32;
    const int c = lane & 31, c8 = lane & 7;
    float v[32];
    const float* src = s.W + (size_t)(k0 + (lane >> 5)) * s.ldw + s.c0 + cb + (c < nv ? c : 0);
#pragma unroll
    for (int i = 0; i < 32; ++i) v[i] = src[(size_t)(2 * i) * s.ldw];
    f32x4 g0 = (f32x4){1.f, 1.f, 1.f, 1.f}, g1 = g0;
    if (s.gain) { g0 = *(const f32x4*)(s.gain + k0 + 8 * c8); g1 = *(const f32x4*)(s.gain + k0 + 8 * c8 + 4); }
    g0 = g0 * s.cs; g1 = g1 * s.cs;
#pragma unroll
    for (int i = 0; i < 32; ++i) scr[(2 * i + (lane >> 5)) * 33 + c] = v[i];
    LDS_WAIT(); asm volatile("" ::: "memory");
    int drow = s.drow0 + cb;
    if (s.map == 1) drow = s.drow0 + 256 * (cb / 128) + (cb % 128);
    else if (s.map == 2) drow = (cb >> 8) * 256 + ((cb & 63) >> 5) * 128 + ((cb >> 6) & 3) * 32;
    else if (s.map == 3) drow = 512 + ((cb & 63) >> 5) * 128 + (cb >> 6) * 32;
    else if (s.map == 4) drow = 512 + (cb < 64 ? 64 + cb : 192 + (cb - 64));
#pragma unroll
    for (int j = 0; j < 4; ++j) { const int n = (lane >> 3) + 8 * j; const LAS float* sp = scr + (8 * c8) * 33 + n;
        v4u o; o.x = pk2(sp[0 * 33] * g0[0], sp[1 * 33] * g0[1]); o.y = pk2(sp[2 * 33] * g0[2], sp[3 * 33] * g0[3]); o.z = pk2(sp[4 * 33] * g1[0], sp[5 * 33] * g1[1]); o.w = pk2(sp[6 * 33] * g1[2], sp[7 * 33] * g1[3]);
        if (n < nv) *(v4u*)(s.dst + (size_t)(drow + n) * s.ldk + s.koff + k0 + 8 * c8) = o; }
    LDS_WAIT(); asm volatile("" ::: "memory");
}
__device__ __forceinline__ void p0_prologue(const Args& a, LAS unsigned char* lds, int gw, int NGW, int wave, int lane_in) {
    int lane = lane_in; asm volatile("" : "+v"(lane));
    LAS float* scr = (LAS float*)(lds + wave * 16384);
    int total = 0;
    for (int i = 0; i < NSEG; ++i) { const Seg s = get_seg(i, a); total += seg_items(s); }
    for (int it = gw; it < total; it += NGW) {
        int r = it, si = 0; Seg s = get_seg(0, a);
        for (;;) { const int n = seg_items(s); if (r < n) break; r -= n; ++si; s = get_seg(si, a); }
        tr_item(s, r, scr, lane);
    }
    { v4u* z = (v4u*)((bf16*)(a.ws + WS_WIN) + (size_t)1296 * DM); const int n16 = 240 * DM * 2 / 16;
      for (int i = gw * 64 + lane; i < n16; i += NGW * 64) z[i] = (v4u){0u, 0u, 0u, 0u}; }
    { float* rc = (float*)(a.ws + WS_ROPEC); float* rs = (float*)(a.ws + WS_ROPES);
      for (int i = gw * 64 + lane; i < SEQ * 32; i += NGW * 64) { const int pos = i >> 5, j = i & 31; const float invf = powf(10000.0f, -(float)(2 * (j & 15)) / 32.0f);
          const float ang = (float)(j < 16 ? (pos >> 6) : (pos & 63)) * invf; float sn, cs; sincosf(ang, &sn, &cs); rc[i] = cs; rs[i] = sn; } }
    bf16* XB = (bf16*)(a.ws + WS_XB); float* SS0 = (float*)(a.ws + WS_SS0); float* SS1 = (float*)(a.ws + WS_SS1); float* SS2 = (float*)(a.ws + WS_SS2); float* SS3 = (float*)(a.ws + WS_SS3);
    for (int m0 = gw * 2; m0 < T; m0 += NGW * 2) {
        f32x4 v[2][4]; float s[2];
#pragma unroll
        for (int r = 0; r < 2; ++r) { const int m = m0 + r; const float* xrow = (m < 16384 ? a.in[0] + (size_t)m * DM : a.in[1] + (size_t)(m - 16384) * DM);
            const f32x4* xr = (const f32x4*)xrow + lane;
#pragma unroll
            for (int j = 0; j < 4; ++j) v[r][j] = xr[64 * j]; }
#pragma unroll
        for (int r = 0; r < 2; ++r) { const int m = m0 + r; float ss = 0.f;
#pragma unroll
            for (int j = 0; j < 4; ++j) ss += (v[r][j].x * v[r][j].x + v[r][j].y * v[r][j].y) + (v[r][j].z * v[r][j].z + v[r][j].w * v[r][j].w);
            s[r] = wave_sum(ss);
            v2u* o8 = (v2u*)(XB + (size_t)m * DM) + lane;
#pragma unroll
            for (int j = 0; j < 4; ++j) o8[64 * j] = (v2u){pk2(v[r][j].x, v[r][j].y), pk2(v[r][j].z, v[r][j].w)};
            if (lane == 0) { SS0[m] = s[r]; SS1[m] = 0.f; SS2[m] = 0.f; SS3[m] = 0.f; } }
    }
}

__device__ __forceinline__ float logsigmoid(float x) { return fminf(x, 0.f) - log1pf(expf(-fabsf(x))); }
__device__ __forceinline__ void gate_scan_item(const Args& a, int item, int lane) {
    unsigned char* ws = a.ws;
    const float* G16 = (const float*)(ws + WS_G16); const float* bias = a.in[10];
    float* SC = (float*)(ws + WS_SC); float* WOLD = (float*)(ws + WS_WOLD);
    {
        const int dir = item & 1, h = (item >> 1) & 3, b = item >> 3;
        const float bi = bias[(2 * dir) * 4 + h], bf_ = bias[(2 * dir + 1) * 4 + h];
        float* sc = SC + (size_t)item * 5 * SEQ;
        float mrun = 0.f;
        float liv[32], lfv[32];
#pragma unroll
        for (int c = 0; c < 32; ++c) { const int t = dir ? (SEQ - 1 - (64 * c + lane)) : (64 * c + lane); const float* g = G16 + (size_t)(b * SEQ + t) * 16;
            liv[c] = g[(2 * dir) * 4 + h]; lfv[c] = g[(2 * dir + 1) * 4 + h]; }
#pragma unroll
        for (int c = 0; c < 32; ++c) {
            const int t = dir ? (SEQ - 1 - (64 * c + lane)) : (64 * c + lane);
            const float li = liv[c] + bi; const float lf = logsigmoid(lfv[c] + bf_);
            float bj = lf;
#pragma unroll
            for (int o = 1; o < 64; o <<= 1) { const float n = __shfl_up(bj, o); if (lane >= o) bj += n; }
            const float av = li - bj; float pm = av;
#pragma unroll
            for (int o = 1; o < 64; o <<= 1) { const float n = __shfl_up(pm, o); if (lane >= o) pm = fmaxf(pm, n); }
            const float Mx = fmaxf(mrun, pm);
            const float Mc = __shfl(Mx, 63), bL = __shfl(bj, 63);
            sc[0 * SEQ + t] = expf(Mc - Mx); sc[1 * SEQ + t] = Mx * LOG2E; sc[2 * SEQ + t] = expf(mrun - Mx); sc[3 * SEQ + t] = expf(-(bj + Mx)); sc[4 * SEQ + t] = expf(av - Mc);
            if (lane == 0) WOLD[item * 32 + c] = expf(mrun - Mc);
            { float* scf = (float*)(ws + WS_SCF) + (size_t)(item * 32 + (t >> 6)) * 256 + (t & 63);
              scf[0] = expf(Mc - Mx); scf[64] = expf(mrun - Mx); scf[128] = expf(av - Mc); scf[192] = expf(mrun - Mc); }
            mrun = bL + Mc;
        }
    }
}
__device__ __forceinline__ void p3b(const Args& a, int gw, int NGW, int lane_in) {
    int lane = lane_in; asm volatile("" : "+v"(lane));
    unsigned char* ws = a.ws;
    bf16* QB = (bf16*)(ws + WS_QB); bf16* KV = (bf16*)(ws + WS_KV);
    const float* rc = (const float*)(ws + WS_ROPEC); const float* rs = (const float*)(ws + WS_ROPES);
    const float* qn = a.in[8]; const float* kn = a.in[9];
    const int j = lane & 31; const float C2 = 0.125f * LOG2E;
    const float qw0 = qn[2 * j], qw1 = qn[2 * j + 1], kw0 = kn[2 * j], kw1 = kn[2 * j + 1];
    for (int m0 = gw * 2; m0 < T; m0 += NGW * 2) {
        unsigned w[2][5]; float cs[2], sn[2];
#pragma unroll
        for (int r = 0; r < 2; ++r) { const int m = m0 + r; const int pos = m & (SEQ - 1); cs[r] = rc[pos * 32 + j]; sn[r] = rs[pos * 32 + j];
#pragma unroll
            for (int i = 0; i < 5; ++i) { const int hh = 2 * i + (lane >> 5);
                const unsigned* p = (hh < 8) ? (const unsigned*)(QB + (size_t)m * 512 + hh * 64 + 2 * j) : (const unsigned*)(KV + (size_t)m * 256 + (hh - 8) * 64 + 2 * j);
                w[r][i] = *p; } }
        asm volatile("" ::: "memory");
#pragma unroll
        for (int r = 0; r < 2; ++r) { const int m = m0 + r;
#pragma unroll
            for (int i = 0; i < 5; ++i) { const int hh = 2 * i + (lane >> 5);
                unsigned* p = (hh < 8) ? (unsigned*)(QB + (size_t)m * 512 + hh * 64 + 2 * j) : (unsigned*)(KV + (size_t)m * 256 + (hh - 8) * 64 + 2 * j);
                const float n0 = (hh < 8) ? qw0 : kw0, n1 = (hh < 8) ? qw1 : kw1, scl = (hh < 8) ? C2 : 1.0f;
                const float x0 = bflo(w[r][i]), x1 = bfhi(w[r][i]);
                float ss = x0 * x0 + x1 * x1;
#pragma unroll
                for (int o = 1; o < 32; o <<= 1) ss += __shfl_xor(ss, o);
                const float rinv = rsqrtf(ss * (1.0f / 64.0f) + EPS);
                const float y0 = x0 * rinv * n0, y1 = x1 * rinv * n1;
                *p = pk2((y0 * cs[r] - y1 * sn[r]) * scl, (y0 * sn[r] + y1 * cs[r]) * scl); } }
    }
}

__device__ __forceinline__ void gate_scan_par(const Args& a, int item, int wave, int lane, LAS float* Lx) {
    unsigned char* ws = a.ws;
    const float* G16 = (const float*)(ws + WS_G16); const float* bias = a.in[10];
    const int dir = item & 1, h = (item >> 1) & 3, b = item >> 3;
    const float bi = bias[(2 * dir) * 4 + h], bf_ = bias[(2 * dir + 1) * 4 + h];
    float* sc = (float*)(ws + WS_SC) + (size_t)item * 5 * SEQ;
    float liv[4], lfv[4], bjv[4], avv[4], pmv[4];
#pragma unroll
    for (int q = 0; q < 4; ++q) { const int c = wave * 4 + q; const int t = dir ? (SEQ - 1 - (64 * c + lane)) : (64 * c + lane); const float* g = G16 + (size_t)(b * SEQ + t) * 16;
        liv[q] = g[(2 * dir) * 4 + h]; lfv[q] = g[(2 * dir + 1) * 4 + h]; }
#pragma unroll
    for (int q = 0; q < 4; ++q) { const int c = wave * 4 + q;
        const float li = liv[q] + bi; float bj = logsigmoid(lfv[q] + bf_);
#pragma unroll
        for (int o = 1; o < 64; o <<= 1) { const float n = __shfl_up(bj, o); if (lane >= o) bj += n; }
        const float av = li - bj; float pm = av;
#pragma unroll
        for (int o = 1; o < 64; o <<= 1) { const float n = __shfl_up(pm, o); if (lane >= o) pm = fmaxf(pm, n); }
        bjv[q] = bj; avv[q] = av; pmv[q] = pm;
        if (lane == 63) { Lx[c] = bj; Lx[32 + c] = pm; } }
    asm volatile("s_waitcnt lgkmcnt(0)\n\ts_barrier" ::: "memory");
    float mrun = 0.f;
    for (int c = 0; c < wave * 4; ++c) mrun = Lx[c] + fmaxf(mrun, Lx[32 + c]);
#pragma unroll
    for (int q = 0; q < 4; ++q) { const int c = wave * 4 + q; const int t = dir ? (SEQ - 1 - (64 * c + lane)) : (64 * c + lane);
        const float bL = Lx[c], Ml = Lx[32 + c];
        const float Mx = fmaxf(mrun, pmv[q]), Mc = fmaxf(mrun, Ml), bj = bjv[q], av = avv[q];
        sc[3 * SEQ + t] = expf(-(bj + Mx));
        float* scf = (float*)(ws + WS_SCF) + (size_t)(item * 32 + (t >> 6)) * 256 + (t & 63);
        scf[0] = expf(Mc - Mx); scf[64] = expf(mrun - Mx); scf[128] = expf(av - Mc); scf[192] = expf(mrun - Mc);
        mrun = bL + Mc; }
}

__device__ __forceinline__ int sigma32(int r) { return (r & 19) | ((r & 4) << 1) | ((r & 8) >> 1); }
__device__ __forceinline__ unsigned cvtpk(float lo, float hi) { unsigned r; asm volatile("v_cvt_pk_bf16_f32 %0, %1, %2" : "=v"(r) : "v"(lo), "v"(hi)); return r; }
#define MFMA_GUARD1(X) asm volatile("s_nop 15\n\ts_nop 7" : "+v"(X))
#define MFMA32(A, B, Cc) __builtin_amdgcn_mfma_f32_32x32x16_bf16(A, B, Cc, 0, 0, 0)
#define CBAR() asm volatile("" ::: "memory")
template <int DIR, bool DIAG> __device__ __forceinline__ void mask_tile(const f32x16& Sin, int tl, int hh, bf16x8& P0, bf16x8& P1) {
    f32x16 S = Sin; MFMA_GUARD1(S);
    unsigned pw[8];
#pragma unroll
    for (int g = 0; g < 16; g += 2) {
        float p0 = S[g], p1 = S[g + 1];
        if (DIAG) { const int s0 = (g & 7) + 8 * hh + 16 * (g >> 3);
            const bool v0 = DIR ? (s0 >= tl) : (s0 <= tl), v1 = DIR ? (s0 + 1 >= tl) : (s0 + 1 <= tl);
            p0 = v0 ? p0 : 0.f; p1 = v1 ? p1 : 0.f; }
        pw[g >> 1] = cvtpk(p0, p1);
    }
    P0 = __builtin_bit_cast(bf16x8, (v4u){pw[0], pw[1], pw[2], pw[3]}); P1 = __builtin_bit_cast(bf16x8, (v4u){pw[4], pw[5], pw[6], pw[7]});
}
#define CFRAG(ks) ({ const int dt_ = (ks) >> 1, s2_ = (ks) & 1; v4u w_; \
        w_.x = cvtpk(C[dt_][8 * s2_ + 0], C[dt_][8 * s2_ + 1]); w_.y = cvtpk(C[dt_][8 * s2_ + 2], C[dt_][8 * s2_ + 3]); \
        w_.z = cvtpk(C[dt_][8 * s2_ + 4], C[dt_][8 * s2_ + 5]); w_.w = cvtpk(C[dt_][8 * s2_ + 6], C[dt_][8 * s2_ + 7]); __builtin_bit_cast(bf16x8, w_); })
#define STORE_NUM(PV, QC, FC, WI, TT) do { const size_t row_ = (size_t)b * SEQ + t0 + 32 * (TT) + tl; \
        if (slice < 4) { bf16* op_ = NUM + row_ * 512; _Pragma("unroll") for (int q4 = 0; q4 < 4; ++q4) { v2u w_; \
            w_.x = cvtpk(FC * PV[4 * q4 + 0] + WI * QC[4 * q4 + 0], FC * PV[4 * q4 + 1] + WI * QC[4 * q4 + 1]); w_.y = cvtpk(FC * PV[4 * q4 + 2] + WI * QC[4 * q4 + 2], FC * PV[4 * q4 + 3] + WI * QC[4 * q4 + 3]); *(v2u*)(op_ + 8 * q4) = w_; } } \
        else if (hh == 0) DEN[row_ * 4] = FC * PV[0] + WI * QC[0]; } while (0)
__device__ __forceinline__ void ml_glds16(const void* gsrc, unsigned lds_dst) { unsigned keep;
    asm volatile("s_mov_b32 %0, m0\n\ts_mov_b32 m0, %2\n\ts_nop 0\n\tglobal_load_lds_dwordx4 %1, off\n\ts_mov_b32 m0, %0" : "=&s"(keep) : "v"(gsrc), "s"(lds_dst) : "memory"); }
template <int DIR> __device__ __forceinline__ void mlstm_block_d(const Args& a, int item, LAS unsigned char* L, int wave, int lane_in) {
    int lane = lane_in; asm volatile("" : "+v"(lane));
    unsigned char* ws = a.ws;
    const int h = (item >> 1) & 3, b = item >> 3;
    const int tl = lane & 31, hh = lane >> 5, slice = wave;
    const unsigned loff = (unsigned)lane * 16u;
    const char* base4 = (wave < 4) ? (const char*)(ws + WS_MQK) + (size_t)(wave >> 1) * ((size_t)T * 1024) : (const char*)a.out + (size_t)((wave - 4) >> 1) * ((size_t)T * 1024);
    const char* srcb = base4 + (size_t)(b * 4 + h) * 524288 + (wave & 1) * 8192 + loff;
    const char* scfp = (const char*)(ws + WS_SCF) + (size_t)item * 32 * 1024 + loff;
    const unsigned lds0 = (unsigned)(uintptr_t)L;
    bf16* NUM = (bf16*)(ws + WS_NUM) + (size_t)DIR * T * 512 + h * 128 + 32 * (slice & 3) + 4 * hh;
    float* DEN = (float*)(ws + WS_DEN) + (size_t)DIR * T * 4 + h;
    constexpr int tA = DIR ? 1 : 0, tB = 1 - tA;
#define ML_ISSUE(TC, BUFO) do { _Pragma("unroll") for (int i_ = 0; i_ < 8; ++i_) ml_glds16(srcb + (size_t)(TC) * 16384 + i_ * 1024, (unsigned)__builtin_amdgcn_readfirstlane(lds0 + (BUFO) + wave * 8192 + i_ * 1024)); \
        if (wave == 7) ml_glds16(scfp + (size_t)(TC) * 1024, (unsigned)__builtin_amdgcn_readfirstlane(lds0 + (BUFO) + 65536)); } while (0)
#define ML_WAITBAR() asm volatile("s_waitcnt vmcnt(0) lgkmcnt(0)\n\ts_barrier" ::: "memory")
    f32x16 C[4];
#pragma unroll
    for (int i = 0; i < 4; ++i) C[i] = (f32x16){};
    { _Pragma("unroll") for (int i_ = 0; i_ < 8; ++i_) ml_glds16(srcb + (size_t)(DIR ? 31 : 0) * 16384 + i_ * 1024, (unsigned)__builtin_amdgcn_readfirstlane(lds0 + wave * 8192 + i_ * 1024)); }
    gate_scan_par(a, item, wave, lane, (LAS float*)(L + 2 * ML_BUF + 6144));
    ML_WAITBAR();
    if (wave == 7) ml_glds16(scfp + (size_t)(DIR ? 31 : 0) * 1024, (unsigned)__builtin_amdgcn_readfirstlane(lds0 + 65536));
    ML_WAITBAR();
#pragma nounroll
    for (int c = 0; c < 32; ++c) {
        const int tc = DIR ? 31 - c : c, t0 = tc * 64;
        const int bufo = (c & 1) * ML_BUF;
        if (c + 1 < 32) ML_ISSUE(DIR ? 30 - c : c + 1, ML_BUF - bufo);
        const LAS unsigned char* Lb = L + bufo;
        LAS unsigned char* Lp = L + 2 * ML_BUF;
        bf16x8 vtw[4]; f32x16 qcA = (f32x16){}, qcB = (f32x16){};
        float fcA = 0.f, wiA = 0.f, fcB = 0.f, wiB = 0.f, wold = 0.f;
        LAS float* Ld = (LAS float*)(Lp + 6144);
        if (wave >= 4) {
            if (wave >= 5) {
                const int which = wave - 5, kt_ = (which == 2) ? tB : tA, qt_ = (which == 0) ? tA : tB;
                f32x16 S = (f32x16){};
#pragma unroll
                for (int ks = 0; ks < 8; ++ks) { const bf16x8 kf = *(const LAS bf16x8*)(Lb + 16384 + (kt_ * 8 + ks) * 1024 + loff), qf = *(const LAS bf16x8*)(Lb + (qt_ * 8 + ks) * 1024 + loff); S = MFMA32(kf, qf, S); }
                bf16x8 P0, P1;
                if (which == 1) mask_tile<DIR, false>(S, tl, hh, P0, P1); else mask_tile<DIR, true>(S, tl, hh, P0, P1);
                *(LAS bf16x8*)(Lp + (which * 2 + 0) * 1024 + loff) = P0; *(LAS bf16x8*)(Lp + (which * 2 + 1) * 1024 + loff) = P1;
            }
            const LAS float* Ls = (const LAS float*)(Lb + 65536);
            const int dtd = wave - 4;
#pragma unroll
            for (int k = 0; k < 4; ++k) { const f32x4 w0 = *(const LAS f32x4*)(Ls + 128 + 16 * k + 8 * hh), w1 = *(const LAS f32x4*)(Ls + 128 + 16 * k + 8 * hh + 4); v4u o;
                o.x = cvtpk(w0[0], w0[1]); o.y = cvtpk(w0[2], w0[3]); o.z = cvtpk(w1[0], w1[1]); o.w = cvtpk(w1[2], w1[3]); vtw[k] = __builtin_bit_cast(bf16x8, o); }
            fcA = Ls[32 * tA + tl]; wiA = Ls[64 + 32 * tA + tl]; fcB = Ls[32 * tB + tl]; wiB = Ls[64 + 32 * tB + tl]; wold = Ls[192];
            asm volatile("s_nop 15\n\ts_nop 7" : "+v"(C[0]));
#pragma unroll
            for (int s2 = 0; s2 < 2; ++s2) { v4u w_;
                w_.x = cvtpk(C[0][8 * s2 + 0], C[0][8 * s2 + 1]); w_.y = cvtpk(C[0][8 * s2 + 2], C[0][8 * s2 + 3]); w_.z = cvtpk(C[0][8 * s2 + 4], C[0][8 * s2 + 5]); w_.w = cvtpk(C[0][8 * s2 + 6], C[0][8 * s2 + 7]);
                const bf16x8 cfr = __builtin_bit_cast(bf16x8, w_);
                const bf16x8 qfa = *(const LAS bf16x8*)(Lb + (tA * 8 + 2 * dtd + s2) * 1024 + loff), qfb = *(const LAS bf16x8*)(Lb + (tB * 8 + 2 * dtd + s2) * 1024 + loff);
                qcA = MFMA32(cfr, qfa, qcA); qcB = MFMA32(cfr, qfb, qcB); }
            if (hh == 0) { Ld[dtd * 64 + tl] = qcA[0]; Ld[dtd * 64 + 32 + tl] = qcB[0]; }
        } else {
            const LAS float* Ls = (const LAS float*)(Lb + 65536);
            {   bf16x8 vt[4]; f32x4 wsv[4][2];
#pragma unroll
                for (int k = 0; k < 4; ++k) {
                    vt[k] = *(const LAS bf16x8*)(Lb + 49152 + (slice * 4 + k) * 1024 + loff);
                    wsv[k][0] = *(const LAS f32x4*)(Ls + 128 + 16 * k + 8 * hh); wsv[k][1] = *(const LAS f32x4*)(Ls + 128 + 16 * k + 8 * hh + 4);
                }
#pragma unroll
                for (int k = 0; k < 4; ++k) { const v4u vv = __builtin_bit_cast(v4u, vt[k]); const f32x4 w0 = wsv[k][0], w1 = wsv[k][1]; v4u o;
                    o.x = cvtpk(bflo(vv.x) * w0[0], bfhi(vv.x) * w0[1]); o.y = cvtpk(bflo(vv.y) * w0[2], bfhi(vv.y) * w0[3]);
                    o.z = cvtpk(bflo(vv.z) * w1[0], bfhi(vv.z) * w1[1]); o.w = cvtpk(bflo(vv.w) * w1[2], bfhi(vv.w) * w1[3]); vtw[k] = __builtin_bit_cast(bf16x8, o); }
            }
            fcA = Ls[32 * tA + tl]; wiA = Ls[64 + 32 * tA + tl]; fcB = Ls[32 * tB + tl]; wiB = Ls[64 + 32 * tB + tl]; wold = Ls[192];
            asm volatile("s_nop 15\n\ts_nop 7" : "+v"(C[0]), "+v"(C[1]), "+v"(C[2]), "+v"(C[3]));
#pragma unroll
            for (int ks = 0; ks < 8; ++ks) { const bf16x8 qf = *(const LAS bf16x8*)(Lb + (tA * 8 + ks) * 1024 + loff); qcA = MFMA32(CFRAG(ks), qf, qcA); if ((ks & 3) == 3) CBAR(); }
#pragma unroll
            for (int ks = 0; ks < 8; ++ks) { const bf16x8 qf = *(const LAS bf16x8*)(Lb + (tB * 8 + ks) * 1024 + loff); qcB = MFMA32(CFRAG(ks), qf, qcB); if ((ks & 3) == 3) CBAR(); }
        }
        asm volatile("s_waitcnt lgkmcnt(0)\n\ts_barrier" ::: "memory");
        if (wave < 4) {
            bf16x8 P[6];
#pragma unroll
            for (int i = 0; i < 6; ++i) P[i] = *(const LAS bf16x8*)(Lp + i * 1024 + loff);
            {   f32x16 pv = (f32x16){}; pv = MFMA32(vtw[2 * tA + 0], P[0], pv); pv = MFMA32(vtw[2 * tA + 1], P[1], pv);
                STORE_NUM(pv, qcA, fcA, wiA, tA); }
            {   f32x16 pv = (f32x16){}; pv = MFMA32(vtw[2 * tA + 0], P[2], pv); pv = MFMA32(vtw[2 * tA + 1], P[3], pv); pv = MFMA32(vtw[2 * tB + 0], P[4], pv); pv = MFMA32(vtw[2 * tB + 1], P[5], pv);
                STORE_NUM(pv, qcB, fcB, wiB, tB); }
#pragma unroll
            for (int dt = 0; dt < 4; ++dt) C[dt] = C[dt] * wold;
#pragma unroll
            for (int k = 0; k < 4; ++k)
#pragma unroll
                for (int dt = 0; dt < 4; ++dt) { const bf16x8 kt = *(const LAS bf16x8*)(Lb + 32768 + (dt * 4 + k) * 1024 + loff); C[dt] = MFMA32(kt, vtw[k], C[dt]); }
        } else {
            const int dtd = wave - 4;
            if (wave == 4) {
                bf16x8 P[6];
#pragma unroll
                for (int i = 0; i < 6; ++i) P[i] = *(const LAS bf16x8*)(Lp + i * 1024 + loff);
                f32x16 pa = (f32x16){}, pb = (f32x16){};
                pa = MFMA32(vtw[2 * tA + 0], P[0], pa); pa = MFMA32(vtw[2 * tA + 1], P[1], pa);
                pb = MFMA32(vtw[2 * tA + 0], P[2], pb); pb = MFMA32(vtw[2 * tA + 1], P[3], pb); pb = MFMA32(vtw[2 * tB + 0], P[4], pb); pb = MFMA32(vtw[2 * tB + 1], P[5], pb);
                const float qna = (Ld[tl] + Ld[64 + tl]) + (Ld[128 + tl] + Ld[192 + tl]), qnb = (Ld[32 + tl] + Ld[96 + tl]) + (Ld[160 + tl] + Ld[224 + tl]);
                if (hh == 0) { DEN[((size_t)b * SEQ + t0 + 32 * tA + tl) * 4] = fcA * pa[0] + wiA * qna; DEN[((size_t)b * SEQ + t0 + 32 * tB + tl) * 4] = fcB * pb[0] + wiB * qnb; }
            }
            C[0] = C[0] * wold;
#pragma unroll
            for (int k = 0; k < 4; ++k) { const bf16x8 kt = *(const LAS bf16x8*)(Lb + 32768 + (dtd * 4 + k) * 1024 + loff); C[0] = MFMA32(kt, vtw[k], C[0]); }
        }
        ML_WAITBAR();
    }
}
__device__ __forceinline__ void mlstm_block(const Args& a, int item, LAS unsigned char* L, int wave, int lane) {
    if (item & 1) mlstm_block_d<1>(a, item, L, wave, lane); else mlstm_block_d<0>(a, item, L, wave, lane);
}

__device__ __forceinline__ void finalize_mem(const Args& a, int gw, int NGW, int lane_in) {
    int lane = lane_in; asm volatile("" : "+v"(lane));
    unsigned char* ws = a.ws;
    const bf16* NUM = (const bf16*)(ws + WS_NUM); const float* DEN = (const float*)(ws + WS_DEN); const float* SC = (const float*)(ws + WS_SC);
    const bf16* OPRE = (const bf16*)(ws + WS_OPRE); bf16* MEM = (bf16*)((unsigned char*)a.out + OUT_AM) + (size_t)T * 512; const float* hn = a.in[11];
    const int hd = lane >> 4;
    const f32x4 w0 = *(const f32x4*)(hn + lane * 8), w1 = *(const f32x4*)(hn + lane * 8 + 4);
    for (int m0 = gw * 2; m0 < T; m0 += NGW * 2) {
        v4u nf[2], nb[2], ov[2]; float df[2], db[2], clf[2], clb[2];
#pragma unroll
        for (int q = 0; q < 2; ++q) { const int m = m0 + q; const int b = m >> 11, t = m & (SEQ - 1);
            nf[q] = *(const v4u*)(NUM + (size_t)m * 512 + lane * 8); nb[q] = *(const v4u*)(NUM + (size_t)T * 512 + (size_t)m * 512 + lane * 8);
            df[q] = DEN[(size_t)m * 4 + hd]; db[q] = DEN[(size_t)T * 4 + (size_t)m * 4 + hd];
            clf[q] = SC[(size_t)((b * 4 + hd) * 2 + 0) * 5 * SEQ + 3 * SEQ + t]; clb[q] = SC[(size_t)((b * 4 + hd) * 2 + 1) * 5 * SEQ + 3 * SEQ + t];
            ov[q] = *(const v4u*)(OPRE + (size_t)m * 512 + lane * 8); }
#pragma unroll
        for (int q = 0; q < 2; ++q) { const int m = m0 + q;
            const float rf = 1.0f / fmaxf(fabsf(df[q]), clf[q]), rb = 1.0f / fmaxf(fabsf(db[q]), clb[q]);
            float hv[8];
            hv[0] = bflo(nf[q].x) * rf + bflo(nb[q].x) * rb; hv[1] = bfhi(nf[q].x) * rf + bfhi(nb[q].x) * rb; hv[2] = bflo(nf[q].y) * rf + bflo(nb[q].y) * rb; hv[3] = bfhi(nf[q].y) * rf + bfhi(nb[q].y) * rb;
            hv[4] = bflo(nf[q].z) * rf + bflo(nb[q].z) * rb; hv[5] = bfhi(nf[q].z) * rf + bfhi(nb[q].z) * rb; hv[6] = bflo(nf[q].w) * rf + bflo(nb[q].w) * rb; hv[7] = bfhi(nf[q].w) * rf + bfhi(nb[q].w) * rb;
            float ss = 0.f;
#pragma unroll
            for (int i = 0; i < 8; ++i) ss += hv[i] * hv[i];
#pragma unroll
            for (int o = 1; o < 16; o <<= 1) ss += __shfl_xor(ss, o);
            const float rinv = rsqrtf(ss * (1.0f / 128.0f) + EPS);
            v4u o; o.x = pk2(hv[0] * rinv * w0[0] * bflo(ov[q].x), hv[1] * rinv * w0[1] * bfhi(ov[q].x)); o.y = pk2(hv[2] * rinv * w0[2] * bflo(ov[q].y), hv[3] * rinv * w0[3] * bfhi(ov[q].y));
            o.z = pk2(hv[4] * rinv * w1[0] * bflo(ov[q].z), hv[5] * rinv * w1[1] * bfhi(ov[q].z)); o.w = pk2(hv[6] * rinv * w1[2] * bflo(ov[q].w), hv[7] * rinv * w1[3] * bfhi(ov[q].w));
            *(v4u*)(MEM + (size_t)m * 512 + lane * 8) = o; }
    }
}
__device__ __forceinline__ void final_norm(const Args& a, int gw, int NGW, int lane_in) {
    int lane = lane_in; asm volatile("" : "+v"(lane));
    const float* SS3 = (const float*)(a.ws + WS_SS3); const float* fnw = a.in[19]; const bf16* XB = (const bf16*)(a.ws + WS_XB);
    f32x4 w[4];
    w[0] = *(const f32x4*)(fnw + 8 * lane); w[1] = *(const f32x4*)(fnw + 8 * lane + 4); w[2] = *(const f32x4*)(fnw + 512 + 8 * lane); w[3] = *(const f32x4*)(fnw + 512 + 8 * lane + 4);
    for (int m0 = gw * 4; m0 < T; m0 += NGW * 4) {
        v4u v[4][2]; float r[4];
#pragma unroll
        for (int q = 0; q < 4; ++q) { r[q] = SS3[m0 + q]; const bf16* p = XB + (size_t)(m0 + q) * DM + 8 * lane; v[q][0] = *(const v4u*)p; v[q][1] = *(const v4u*)(p + 512); }
#pragma unroll
        for (int q = 0; q < 4; ++q) { const float rr = rsqrtf(r[q] * (1.0f / 1024.0f) + EPS); float* o = a.out + (size_t)(m0 + q) * DM + 8 * lane;
#pragma unroll
            for (int hlf = 0; hlf < 2; ++hlf) { const v4u x = v[q][hlf];
                const f32x4 y0 = (f32x4){bflo(x.x), bfhi(x.x), bflo(x.y), bfhi(x.y)} * rr * w[2 * hlf], y1 = (f32x4){bflo(x.z), bfhi(x.z), bflo(x.w), bfhi(x.w)} * rr * w[2 * hlf + 1];
                *(f32x4*)(o + 512 * hlf) = y0; *(f32x4*)(o + 512 * hlf + 4) = y1; } }
    }
}

#define XB_TMO      128
#define XB_XCNT(j)  (256  + 64 * (j))
#define XB_XSUB(j)  (1280 + 64 * (j))
#define XB_XGEN(j)  (2304 + 64 * (j))
#define XB_TOP      3328
#define XB_TOPGEN   3392
#define XCD_BAR_WORDS 3456
#define XB_SPIN_CAP (1u << 18)

__device__ __forceinline__ unsigned xb_ld(unsigned* p)              { return __hip_atomic_load(p, __ATOMIC_RELAXED, __HIP_MEMORY_SCOPE_AGENT); }
__device__ __forceinline__ unsigned xb_add(unsigned* p, unsigned v) { return __hip_atomic_fetch_add(p, v, __ATOMIC_RELAXED, __HIP_MEMORY_SCOPE_AGENT); }
__device__ __forceinline__ unsigned xb_xcc_id() { return (unsigned)__builtin_amdgcn_s_getreg((3 << 11) | 20) & 0xFu; }
#define XB_SPIN(cond, bar) do { unsigned _sp = 0; while (cond) { __builtin_amdgcn_s_sleep(1); \
    if ((++_sp & 255u) == 0u) { if (xb_ld(&(bar)[XB_TMO])) break; if (_sp > XB_SPIN_CAP) { atomicAdd(&(bar)[XB_TMO], 1u); break; } } } } while (0)

struct XcdBarrier {
    unsigned* bar; unsigned x;
    volatile LAS unsigned* st;
};

__device__ __forceinline__ XcdBarrier xcd_barrier_post(unsigned* bar, volatile LAS unsigned* st) {
    XcdBarrier b; b.bar = bar; b.x = xb_xcc_id(); b.st = st;
    if (threadIdx.x == 0) (void)xb_add(&bar[XB_XCNT(b.x)], 1u);
    return b;
}
__device__ __forceinline__ void xcd_barrier_complete(unsigned* bar, unsigned x, unsigned& nloc, unsigned& nx) {
    const unsigned G = gridDim.x * gridDim.y * gridDim.z;
    unsigned sum, cnt, mine, sp = 0u;
    for (;;) {
        sum = 0u; cnt = 0u; mine = 0u;
#pragma unroll
        for (unsigned j = 0; j < 16; ++j) { const unsigned c = xb_ld(&bar[XB_XCNT(j)]); sum += c; cnt += (c > 0u) ? 1u : 0u; mine = (j == x) ? c : mine; }
        if (sum == G) break;
        __builtin_amdgcn_s_sleep(1);
        if ((++sp & 255u) == 0u) { if (xb_ld(&bar[XB_TMO])) break; if (sp > XB_SPIN_CAP) { atomicAdd(&bar[XB_TMO], 1u); break; } }
    }
    nloc = mine > 0u ? mine : 1u; nx = cnt > 0u ? cnt : 1u;
}

__device__ __forceinline__ void xcd_barrier(const XcdBarrier& b) {
    asm volatile("s_waitcnt vmcnt(0)" ::: "memory");
    __syncthreads();
    if (threadIdx.x == 0) {
        unsigned* bar = b.bar;
        __builtin_amdgcn_s_waitcnt(0);
        unsigned nloc = b.st[0], nx = b.st[1];
        if (nloc == 0u) { xcd_barrier_complete(bar, b.x, nloc, nx); b.st[0] = nloc; b.st[1] = nx; }
        const unsigned old = xb_add(&bar[XB_XSUB(b.x)], 1u);
        const unsigned gen = old / nloc;
        if (old + 1u == (gen + 1u) * nloc) {
            __builtin_amdgcn_fence(__ATOMIC_RELEASE, "agent");
            asm volatile("s_waitcnt vmcnt(0)" ::: "memory");
            const unsigned og = xb_add(&bar[XB_TOP], 1u);
            const unsigned tg = og / nx;
            if (og + 1u == (tg + 1u) * nx) xb_add(&bar[XB_TOPGEN], 1u);
            else XB_SPIN(xb_ld(&bar[XB_TOPGEN]) == tg, bar);
            __builtin_amdgcn_fence(__ATOMIC_ACQUIRE, "agent");
            xb_add(&bar[XB_XGEN(b.x)], 1u);
            asm volatile("s_waitcnt vmcnt(0)" ::: "memory");
        } else {
            XB_SPIN(xb_ld(&bar[XB_XGEN(b.x)]) == gen, bar);
            __builtin_amdgcn_fence(__ATOMIC_ACQUIRE, "agent");
            asm volatile("s_waitcnt vmcnt(0)" ::: "memory");
        }
    }
    __syncthreads();
}

__global__ void __launch_bounds__(NWAVES * 64, 2) mega_fwd(Args args) {
    extern __shared__ __attribute__((aligned(16))) unsigned char lds[];
    cg::grid_group grid = cg::this_grid();
    LAS unsigned char* L = (LAS unsigned char*)lds;
    volatile LAS unsigned* MISC = (volatile LAS unsigned*)(L + MISC_OFF);
    const int tid = threadIdx.x, lane = tid & 63, wave = __builtin_amdgcn_readfirstlane(tid >> 6);
    const int G = gridDim.x; const int bx = blockIdx.x;
    const int vcu = (G % 8 == 0) ? (bx % 8) * (G / 8) + bx / 8 : bx;
    const int gw = vcu * NWAVES + wave, NGW = G * NWAVES;
    unsigned char* ws = args.ws;
    for (int u = tid; u < 64; u += NWAVES * 64) ((LAS unsigned*)(L + MISC_OFF))[u] = 0u;
    __syncthreads();
    const XcdBarrier xbar = xcd_barrier_post((unsigned*)(ws + WS_CTL) + CW_BAR, MISC + 8);
    if (args.ws == nullptr) grid.sync();
#define GSYNC() xcd_barrier(xbar)
    bf16* XB = (bf16*)(ws + WS_XB); bf16* Hb = (bf16*)(ws + WS_H); bf16* WIN = (bf16*)(ws + WS_WIN);

#define EPI_INIT(E) do { E.ssin = nullptr; E.ssout = nullptr; E.x0 = args.in[0]; E.x1 = args.in[1]; E.f32buf = args.out; E.b0 = nullptr; E.q = (bf16*)(ws + WS_QB); E.kv = (bf16*)(ws + WS_KV); \
    E.mqk = (bf16*)(ws + WS_MQK); E.opre = (bf16*)(ws + WS_OPRE); E.g16 = (float*)(ws + WS_G16); E.gate = nullptr; E.qnw = args.in[8]; E.knw = args.in[9]; E.ropec = (const float*)(ws + WS_ROPEC); E.ropes = (const float*)(ws + WS_ROPES); } while (0)
#define RUN_GEMM(EPI_T, E, Aptr, Bptr, Mv, Nv, Kv) do { pg8::Gemm g; g.A = (Aptr); g.Bt = (Bptr); g.M = (Mv); g.N = (Nv); g.K = (Kv); pg8::StaticOrder S; S.init(g.M, g.N, G, bx); \
    pg8::gemm_phase<EPI_T, pg8::StaticOrder, true, true>(L, g, S, E); } while (0)
    p0_prologue(args, L, gw, NGW, wave, lane);
    GSYNC();
    { typedef pg8::EpiG<pg8::M_SWIGLU> EP; EP E; EPI_INIT(E); E.ssin = (float*)(ws + WS_SS0); E.b0 = Hb; RUN_GEMM(EP, E, XB, (bf16*)(ws + WS_W1GU), T, 2 * DFF, DM); }
    GSYNC();
    { typedef pg8::EpiG<pg8::M_RES, 1, 0, 1> EP; EP E; EPI_INIT(E); E.b0 = XB; E.ssout = (float*)(ws + WS_SS1);     RUN_GEMM(EP, E, Hb, (bf16*)(ws + WS_W1D), T, DM, DFF); }
    GSYNC();
    { typedef pg8::EpiG<pg8::M_WINA> EP; EP E; EPI_INIT(E); E.ssin = (float*)(ws + WS_SS1); RUN_GEMM(EP, E, XB, WIN, T, 2560, DM); }
    { typedef pg8::EpiG<pg8::M_KVT> EP; EP E; EPI_INIT(E); E.ssin = (float*)(ws + WS_SS1); E.b0 = (bf16*)args.out; RUN_GEMM(EP, E, WIN + (size_t)2048 * DM, XB, 1024, T, DM); }
    GSYNC();
    {
        unsigned* qctr = (unsigned*)(ws + WS_CTL);
        for (;;) {
            if (tid == 0) MISC[0] = __hip_atomic_fetch_add(qctr, 1u, __ATOMIC_RELAXED, __HIP_MEMORY_SCOPE_AGENT);
            __syncthreads();
            const int u = __builtin_amdgcn_readfirstlane((int)MISC[0]);
            __syncthreads();
            if (u >= N_MLSTM_BLK + N_ATT_UNITS) break;
            if (u < N_MLSTM_BLK) { mlstm_block(args, u, L, wave, lane); }
            else { const int au = u - N_MLSTM_BLK; const int qb = au & 7, gq = (au >> 3) & 3, kvh = (au >> 5) & 1, b = au >> 6;
                attn_body::attn_unit<8>(b, kvh * 4 + gq, qb, (const attn_body::bf16*)(ws + WS_QB), (const attn_body::bf16*)(ws + WS_KV), (const attn_body::bf16*)(ws + WS_KV) + 128, (attn_body::bf16*)((unsigned char*)args.out + OUT_AM), (char*)lds); }
        }
    }
    GSYNC();
    { typedef pg8::EpiG<pg8::M_GAGM> EP; EP E; EPI_INIT(E); E.ssin = (float*)(ws + WS_SS1); E.b0 = (bf16*)(ws + WS_GA); E.gate = (bf16*)args.out; RUN_GEMM(EP, E, XB, WIN + (size_t)3072 * DM, T, 2048, DM); }
    finalize_mem(args, gw, NGW, lane);
    GSYNC();
    { typedef pg8::EpiG<pg8::M_UPF> EP; EP E; EPI_INIT(E); E.q = (bf16*)(ws + WS_GA); E.gate = (bf16*)args.out; E.b0 = (bf16*)(ws + WS_MERGED); { pg8::Gemm g; g.A = (bf16*)((unsigned char*)args.out + OUT_AM); g.Bt = (bf16*)(ws + WS_WA); g.M = T; g.N = DM; g.K = 512; pg8::HalfOrder S; S.init(T, DM, G, bx);
        pg8::gemm_phase<EP, pg8::HalfOrder, true, true>(L, g, S, E); } }
    GSYNC();
    { typedef pg8::EpiG<pg8::M_RES, 1, 0, 1> EP; EP E; EPI_INIT(E); E.b0 = XB; E.ssout = (float*)(ws + WS_SS2); RUN_GEMM(EP, E, (bf16*)(ws + WS_MERGED), (bf16*)(ws + WS_WOUT), T, DM, DM); }
    GSYNC();
    { typedef pg8::EpiG<pg8::M_SWIGLU> EP; EP E; EPI_INIT(E); E.ssin = (float*)(ws + WS_SS2); E.b0 = Hb; RUN_GEMM(EP, E, XB, (bf16*)(ws + WS_W2GU), T, 2 * DFF, DM); }
    GSYNC();
    { typedef pg8::EpiG<pg8::M_RES, 1, 0, 1> EP; EP E; EPI_INIT(E); E.b0 = XB; E.ssout = (float*)(ws + WS_SS3); RUN_GEMM(EP, E, Hb, (bf16*)(ws + WS_W2D), T, DM, DFF); }
    GSYNC();
    final_norm(args, gw, NGW, lane);
}

extern "C" void kernel_launch(void* const* d_in, const int* in_sizes, int n_in, void* d_out, int out_size, void* d_ws, size_t ws_size, hipStream_t stream) {
    static int grid = 0;
    if (grid == 0) {
        int dev = 0, cus = 0, per_cu = 0;
        if (n_in != 20 || out_size != T * DM || ws_size < WS_END) { fprintf(stderr, "kernel_launch: unexpected shapes n_in %d out %d ws %zu\n", n_in, out_size, ws_size); grid = -1; return; }
        (void)hipGetDevice(&dev);
        (void)hipDeviceGetAttribute(&cus, hipDeviceAttributeMultiprocessorCount, dev);
        (void)hipFuncSetAttribute((const void*)mega_fwd, hipFuncAttributeMaxDynamicSharedMemorySize, LDS_BYTES);
        (void)hipOccupancyMaxActiveBlocksPerMultiprocessor(&per_cu, (const void*)mega_fwd, NWAVES * 64, LDS_BYTES);
        if (per_cu < 1) per_cu = 1;
        if (per_cu > 1) per_cu = 1;
        grid = cus * per_cu;
        fprintf(stderr, "kernel_launch: grid %d ws %zu\n", grid, ws_size);
    }
    if (grid < 0) return;
    (void)hipMemsetAsync((char*)d_ws + WS_CTL, 0, CTL_ZERO_BYTES, stream);
    Args a{};
    for (int i = 0; i < 20; ++i) a.in[i] = (const float*)d_in[i];
    a.out = (float*)d_out; a.ws = (unsigned char*)d_ws;
    void* kargs[] = {&a};
    hipError_t e = hipLaunchCooperativeKernel((void*)mega_fwd, dim3(grid), dim3(NWAVES * 64), kargs, LDS_BYTES, stream);
    if (e != hipSuccess) fprintf(stderr, "kernel_launch: cooperative launch failed: %s (grid %d)\n", hipGetErrorString(e), grid);
}
```

```cpp
#include <hip/hip_runtime.h>
#include <hip/hip_cooperative_groups.h>
#include <cstdio>
#include <cstdint>
namespace pg8 {
#define PG8_LAS __attribute__((address_space(3)))
typedef unsigned short bf16_t;
typedef short bf16x8 __attribute__((ext_vector_type(8)));
typedef float f32x4 __attribute__((ext_vector_type(4)));
typedef unsigned u32x4 __attribute__((ext_vector_type(4)));
constexpr int BM = 256, BK = 64, HALF = 128, HTB = HALF * BK * 2  , STAGE_BYTES = 8 * HTB, NXCD = 8, WGM = 8;

__host__ __device__ __forceinline__ int lds_byte(int r, int c) { const int st = (r >> 4) * 2 + (c >> 5), rr = r & 15, cc = c & 31, ob = rr * 64 + cc * 2; return st * 1024 + (ob ^ (((ob >> 9) & 1) << 5)); }
__host__ __device__ __forceinline__ void stage_rc(int b, int& R, int& C) { const int st = b / 1024, sb = b % 1024, swz = sb ^ (((sb >> 9) & 1) << 5); R = (st >> 1) * 16 + swz / 64; C = (st & 1) * 32 + (swz % 64) / 2; }
__host__ __device__ __forceinline__ int perm32(int rho) { const int n = rho >> 4, i = rho & 15; return 8 * (i >> 2) + 4 * n + (i & 3); }

struct Unit { int pm, pn; };
struct Gemm { const bf16_t* A; const bf16_t* Bt; int M, N, K; };

struct StaticOrder {
    int nM, nN, nwg, G, c;
    __host__ __device__ void init(int M, int N, int G_, int c_) { nM = M / BM; nN = N / BM; nwg = nM * nN; G = G_; c = c_; }
    __host__ __device__ bool next(int i, Unit& u) const {
        const long L = (long)i * G + c; if (L >= nwg) return false;
        int wgid = (int)L; { const int q = nwg / NXCD, r = nwg % NXCD, xcd = wgid % NXCD, off = wgid / NXCD; wgid = (xcd < r ? xcd * (q + 1) : r * (q + 1) + (xcd - r) * q) + off; }
        const int nig = WGM * nN, gid = wgid / nig, fm = gid * WGM, gsz = (nM - fm) < WGM ? (nM - fm) : WGM;
        u.pm = fm + ((wgid % nig) % gsz); u.pn = (wgid % nig) / gsz; return true;
    }
    __device__ __forceinline__ void a_ready(const Unit&) const {}
    __device__ __forceinline__ void done(const Unit&) const {}
};

struct HalfOrder {
    StaticOrder so;
    __host__ __device__ void init(int M, int N, int G_, int c_) { so.init(M, N, G_, c_); }
    __host__ __device__ bool next(int i, Unit& u) const { if (!so.next(i >> 1, u)) return false; if (i & 1) { u.pm += so.nM; u.pn += so.nN; } return true; }
    __device__ __forceinline__ void a_ready(const Unit&) const {}
    __device__ __forceinline__ void done(const Unit&) const {}
};
__device__ __forceinline__ unsigned cvt_pk_bf16(float lo, float hi) { unsigned r; asm volatile("v_cvt_pk_bf16_f32 %0, %1, %2" : "=v"(r) : "v"(lo), "v"(hi)); return r; }
typedef float f32x2 __attribute__((ext_vector_type(2)));
enum { M_SWIGLU = 1, M_RES = 2, M_WINA = 3, M_KVT = 4, M_GAGM = 5, M_UPA = 6, M_UPM = 7, M_UPF = 8 };
__device__ __forceinline__ float sigm(float v) { return __builtin_amdgcn_rcpf(1.0f + __builtin_amdgcn_exp2f(-1.4426950408889634f * v)); }
__device__ __forceinline__ u32x4 pack8(f32x4 a, f32x4 b) { u32x4 w; w.x = cvt_pk_bf16(a[0], a[1]); w.y = cvt_pk_bf16(a[2], a[3]); w.z = cvt_pk_bf16(b[0], b[1]); w.w = cvt_pk_bf16(b[2], b[3]); return w; }
__device__ __forceinline__ void unpack8(u32x4 w, f32x4& a, f32x4& b) {
    a[0] = __uint_as_float(w.x << 16); a[1] = __uint_as_float(w.x & 0xffff0000u); a[2] = __uint_as_float(w.y << 16); a[3] = __uint_as_float(w.y & 0xffff0000u);
    b[0] = __uint_as_float(w.z << 16); b[1] = __uint_as_float(w.z & 0xffff0000u); b[2] = __uint_as_float(w.w << 16); b[3] = __uint_as_float(w.w & 0xffff0000u); }
constexpr int TOK = 49152, NPROMPT = 16384;
__device__ __forceinline__ int sigma32e(int r) { return (r & 19) | ((r & 4) << 1) | ((r & 8) >> 1); }
template <int mode, int reskind = 0, int wf32 = 0, int wbf = 0> struct EpiG {
    static constexpr bool PERM = true, AFTER_DRAIN = false, HAS_MID = (mode == M_UPF);
    const float* ssin; float* ssout; const float* x0; const float* x1; float* f32buf;
    bf16_t* b0; bf16_t* q; bf16_t* kv; bf16_t* mqk; bf16_t* opre; float* g16; const bf16_t* gate;
    const float* qnw; const float* knw; const float* ropec; const float* ropes;
    __device__ __forceinline__ bool is_first_half(const Unit& u) const { return u.pm < TOK / BM; }
    __device__ __forceinline__ void mid(f32x4 (&acc)[2][2][4][2], const Unit& u, int wr, int wc, int fr, int fq) const {
        const int rowb = u.pm * BM + wr * 64 + fr; const int cw = wc * 32 + 8 * fq;
#pragma unroll
        for (int ai = 0; ai < 2; ++ai) {
            u32x4 ga[4][2], gm[4][2];
#pragma unroll
            for (int m = 0; m < 4; ++m) { const int row = rowb + ai * HALF + m * 16;
#pragma unroll
                for (int bj = 0; bj < 2; ++bj) { const size_t o = (size_t)row * 1024 + u.pn * BM + bj * HALF + cw; ga[m][bj] = *(const u32x4*)(q + o); gm[m][bj] = *(const u32x4*)(gate + o); } }
            asm volatile("" ::: "memory");
#pragma unroll
            for (int m = 0; m < 4; ++m)
#pragma unroll
                for (int bj = 0; bj < 2; ++bj) { f32x4 a0, a1, m0, m1; unpack8(ga[m][bj], a0, a1); unpack8(gm[m][bj], m0, m1);
#pragma unroll
                    for (int i = 0; i < 4; ++i) { acc[ai][bj][m][0][i] *= a0[i] * __builtin_amdgcn_rcpf(m0[i]); acc[ai][bj][m][1][i] *= a1[i] * __builtin_amdgcn_rcpf(m1[i]); } }
            asm volatile("" ::: "memory"); }
    }
    __device__ __forceinline__ void operator()(const f32x4 (&acc)[2][2][4][2], const Unit& u, int wr, int wc, int fr, int fq) const {
        const int rowb = u.pm * BM + wr * 64 + fr;
        const int cw = wc * 32 + 8 * fq;
        if (mode == M_SWIGLU) {
#pragma unroll
            for (int ai = 0; ai < 2; ++ai)
#pragma unroll
                for (int m = 0; m < 4; ++m) { const int row = rowb + ai * HALF + m * 16; const float r = rsqrtf(ssin[row] * (1.0f / 1024.0f) + 1e-6f);
                    f32x4 g0 = acc[ai][0][m][0] * r, g1 = acc[ai][0][m][1] * r, u0 = acc[ai][1][m][0] * r, u1 = acc[ai][1][m][1] * r;
#pragma unroll
                    for (int i = 0; i < 4; ++i) { g0[i] = g0[i] * sigm(g0[i]) * u0[i]; g1[i] = g1[i] * sigm(g1[i]) * u1[i]; }
                    *(u32x4*)(b0 + (size_t)row * 2816 + u.pn * 128 + cw) = pack8(g0, g1); }
        } else if (mode == M_RES) {
            u32x4 rball[2][4][2];
            if (reskind == 1) {
#pragma unroll
                for (int ai = 0; ai < 2; ++ai)
#pragma unroll
                    for (int m = 0; m < 4; ++m)
#pragma unroll
                        for (int bj = 0; bj < 2; ++bj) rball[ai][m][bj] = *(const u32x4*)(b0 + (size_t)(rowb + ai * HALF + m * 16) * 1024 + u.pn * BM + bj * HALF + cw);
                asm volatile("" ::: "memory"); }
#pragma unroll
            for (int ai = 0; ai < 2; ++ai) {
                f32x4 rf[4][2][2]; u32x4 rb[4][2];
#pragma unroll
                for (int m = 0; m < 4; ++m) { const int row = rowb + ai * HALF + m * 16;
#pragma unroll
                    for (int bj = 0; bj < 2; ++bj) { const int col = u.pn * BM + bj * HALF + cw;
                        if (reskind == 0) { const float* p = (row < NPROMPT ? x0 + (size_t)row * 1024 : x1 + (size_t)(row - NPROMPT) * 1024) + col; rf[m][bj][0] = *(const f32x4*)p; rf[m][bj][1] = *(const f32x4*)(p + 4); }
                        else if (reskind == 1) rb[m][bj] = rball[ai][m][bj];
                        else { const float* p = f32buf + (size_t)row * 1024 + col; rf[m][bj][0] = *(const f32x4*)p; rf[m][bj][1] = *(const f32x4*)(p + 4); } } }
                asm volatile("" ::: "memory");
#pragma unroll
                for (int m = 0; m < 4; ++m) { const int row = rowb + ai * HALF + m * 16; float ssq = 0.f;
#pragma unroll
                    for (int bj = 0; bj < 2; ++bj) { const int col = u.pn * BM + bj * HALF + cw; f32x4 r0, r1;
                        if (reskind == 1) unpack8(rb[m][bj], r0, r1); else { r0 = rf[m][bj][0]; r1 = rf[m][bj][1]; }
                        const f32x4 y0 = r0 + acc[ai][bj][m][0], y1 = r1 + acc[ai][bj][m][1];
                        ssq += (y0[0] * y0[0] + y0[1] * y0[1]) + (y0[2] * y0[2] + y0[3] * y0[3]) + (y1[0] * y1[0] + y1[1] * y1[1]) + (y1[2] * y1[2] + y1[3] * y1[3]);
                        if (wf32) { float* p = f32buf + (size_t)row * 1024 + col; *(f32x4*)p = y0; *(f32x4*)(p + 4) = y1; }
                        if (wbf) *(u32x4*)(b0 + (size_t)row * 1024 + col) = pack8(y0, y1); }
                    ssq += __shfl_xor(ssq, 16); ssq += __shfl_xor(ssq, 32);
                    if (fq == 0) unsafeAtomicAdd(ssout + row, ssq); }
                asm volatile("" ::: "memory"); }
        } else if (mode == M_WINA && u.pn < 3) {
            const int pn = u.pn; const bool isq = pn < 2, nrm = isq || wc < 2;
            const float* nw = isq ? qnw : knw; const float scl = isq ? 0.125f * 1.4426950408889634f : 1.0f;
            f32x4 w00 = (f32x4){1.f, 1.f, 1.f, 1.f}, w01 = w00, w10 = w00, w11 = w00;
            if (nrm) { w00 = *(const f32x4*)(nw + 8 * fq); w01 = *(const f32x4*)(nw + 8 * fq + 4); w10 = *(const f32x4*)(nw + 32 + 8 * fq); w11 = *(const f32x4*)(nw + 32 + 8 * fq + 4); }
#pragma unroll
            for (int ai = 0; ai < 2; ++ai)
#pragma unroll
                for (int m = 0; m < 4; ++m) { const int row = rowb + ai * HALF + m * 16; const float r = rsqrtf(ssin[row] * (1.0f / 1024.0f) + 1e-6f);
                    f32x4 a0 = acc[ai][0][m][0] * r, a1 = acc[ai][0][m][1] * r, b0v = acc[ai][1][m][0] * r, b1v = acc[ai][1][m][1] * r;
                    if (nrm) {
                        float ss = (a0[0] * a0[0] + a0[1] * a0[1]) + (a0[2] * a0[2] + a0[3] * a0[3]) + (a1[0] * a1[0] + a1[1] * a1[1]) + (a1[2] * a1[2] + a1[3] * a1[3])
                                 + (b0v[0] * b0v[0] + b0v[1] * b0v[1]) + (b0v[2] * b0v[2] + b0v[3] * b0v[3]) + (b1v[0] * b1v[0] + b1v[1] * b1v[1]) + (b1v[2] * b1v[2] + b1v[3] * b1v[3]);
                        ss += __shfl_xor(ss, 16); ss += __shfl_xor(ss, 32);
                        const float rinv = rsqrtf(ss * (1.0f / 64.0f) + 1e-6f);
                        const int pos = row & 2047;
                        const f32x4 c0 = *(const f32x4*)(ropec + pos * 32 + 4 * fq), s0 = *(const f32x4*)(ropes + pos * 32 + 4 * fq);
                        const f32x4 c1 = *(const f32x4*)(ropec + pos * 32 + 16 + 4 * fq), s1 = *(const f32x4*)(ropes + pos * 32 + 16 + 4 * fq);
                        a0 = a0 * rinv * w00; a1 = a1 * rinv * w01; b0v = b0v * rinv * w10; b1v = b1v * rinv * w11;
                        const f32x4 ra0 = (f32x4){a0[0] * c0[0] - a0[1] * s0[0], a0[0] * s0[0] + a0[1] * c0[0], a0[2] * c0[1] - a0[3] * s0[1], a0[2] * s0[1] + a0[3] * c0[1]} * scl;
                        const f32x4 ra1 = (f32x4){a1[0] * c0[2] - a1[1] * s0[2], a1[0] * s0[2] + a1[1] * c0[2], a1[2] * c0[3] - a1[3] * s0[3], a1[2] * s0[3] + a1[3] * c0[3]} * scl;
                        const f32x4 rb0 = (f32x4){b0v[0] * c1[0] - b0v[1] * s1[0], b0v[0] * s1[0] + b0v[1] * c1[0], b0v[2] * c1[1] - b0v[3] * s1[1], b0v[2] * s1[1] + b0v[3] * c1[1]} * scl;
                        const f32x4 rb1 = (f32x4){b1v[0] * c1[2] - b1v[1] * s1[2], b1v[0] * s1[2] + b1v[1] * c1[2], b1v[2] * c1[3] - b1v[3] * s1[3], b1v[2] * s1[3] + b1v[3] * c1[3]} * scl;
                        bf16_t* dp = isq ? q + (size_t)row * 512 + (pn * 4 + wc) * 64 + 8 * fq : kv + (size_t)row * 256 + wc * 64 + 8 * fq;
                        *(u32x4*)dp = pack8(ra0, ra1); *(u32x4*)(dp + 32) = pack8(rb0, rb1);
                    } else {
                        bf16_t* dp = kv + (size_t)row * 256 + 128 + (wc - 2) * 32 + 8 * fq;
                        *(u32x4*)dp = pack8(a0, a1); *(u32x4*)(dp + 64) = pack8(b0v, b1v);
                    } }
        } else if (mode == M_WINA) {
            bf16_t* dst; int ld, cofs, kind = 0; const int pn = u.pn;
            if (pn < 2) { dst = q; ld = 512; cofs = pn * 256; }
            else if (pn == 2) { dst = kv; ld = 256; cofs = 0; }
            else if (pn < 5) { dst = mqk; ld = 0; cofs = (pn - 3) * 256; kind = 3; }
            else if (pn == 5) { dst = mqk; ld = 0; cofs = 0; kind = 2; }
            else if (pn < 8) { dst = opre; ld = 512; cofs = (pn - 6) * 256; kind = 1; }
            else { dst = mqk + (size_t)TOK * 512; ld = 1; cofs = (pn - 8) * 256; kind = 3; }
#pragma unroll
            for (int ai = 0; ai < 2; ++ai)
#pragma unroll
                for (int m = 0; m < 4; ++m) { const int row = rowb + ai * HALF + m * 16; const float r = rsqrtf(ssin[row] * (1.0f / 1024.0f) + 1e-6f);
#pragma unroll
                    for (int bj = 0; bj < 2; ++bj) { f32x4 v0 = acc[ai][bj][m][0] * r, v1 = acc[ai][bj][m][1] * r;
                        if (kind == 2) { if (bj == 0 && wc == 0 && fq < 2) { float* gp = g16 + (size_t)row * 16 + 8 * fq; *(f32x4*)gp = v0; *(f32x4*)(gp + 4) = v1; } }
                        else if (kind == 3) {
                            const int c0 = cofs + bj * HALF + cw, hd = c0 >> 7, d0 = c0 & 127, ks = d0 >> 4, hh = (d0 >> 3) & 1;
                            const int bb = row >> 11, t = row & 2047, chunk = t >> 6, ti = (t >> 5) & 1; int r = t & 31; if (ld) r = sigma32e(r);
                            const size_t off = ((((size_t)((bb * 4 + hd) * 32 + chunk) * 2 + ti) * 8 + ks) * 64 + hh * 32 + r) * 8;
                            *(u32x4*)(dst + off) = pack8(v0, v1); }
                        else { if (kind == 1) {
#pragma unroll
                                for (int i = 0; i < 4; ++i) { v0[i] = sigm(v0[i]); v1[i] = sigm(v1[i]); } }
                            *(u32x4*)(dst + (size_t)row * ld + cofs + bj * HALF + cw) = pack8(v0, v1); } } }
        } else if (mode == M_KVT) {
            f32x4 rc[2][2];
#pragma unroll
            for (int bj = 0; bj < 2; ++bj) { const float* sp = ssin + u.pn * BM + bj * HALF + cw;
#pragma unroll
                for (int n = 0; n < 2; ++n) { const f32x4 s = *(const f32x4*)(sp + 4 * n);
#pragma unroll
                    for (int i = 0; i < 4; ++i) rc[bj][n][i] = rsqrtf(s[i] * (1.0f / 1024.0f) + 1e-6f); } }
#pragma unroll
            for (int ai = 0; ai < 2; ++ai)
#pragma unroll
                for (int m = 0; m < 4; ++m) { const int row = rowb + ai * HALF + m * 16;
#pragma unroll
                    for (int bj = 0; bj < 2; ++bj) {
                        const int isv = row >> 9, nn = row & 511, hd = nn >> 7, d = nn & 127, m0 = u.pn * BM + bj * HALF + cw;
                        const int bb = m0 >> 11, s = m0 & 2047, chunk = s >> 6, k = (s >> 4) & 3, hh = (s >> 3) & 1;
                        const int l64 = hh * 32 + (isv ? (d & 31) : sigma32e(d & 31));
                        const size_t off = (((((size_t)(bb * 4 + hd) * 32 + chunk) * 4 + (d >> 5)) * 4 + k) * 64 + l64) * 8;
                        *(u32x4*)(b0 + (size_t)isv * TOK * 512 + off) = pack8(acc[ai][bj][m][0] * rc[bj][0], acc[ai][bj][m][1] * rc[bj][1]); } }
        } else if (mode == M_GAGM) {
#pragma unroll
            for (int ai = 0; ai < 2; ++ai)
#pragma unroll
                for (int m = 0; m < 4; ++m) { const int row = rowb + ai * HALF + m * 16; const float r = rsqrtf(ssin[row] * (1.0f / 1024.0f) + 1e-6f);
#pragma unroll
                    for (int bj = 0; bj < 2; ++bj) { f32x4 v0 = acc[ai][bj][m][0] * r, v1 = acc[ai][bj][m][1] * r;
#pragma unroll
                        for (int i = 0; i < 4; ++i) { v0[i] = sigm(v0[i]); v1[i] = sigm(v1[i]); }
                        bf16_t* gd = (u.pn < 4) ? b0 + (size_t)row * 1024 + u.pn * BM : (bf16_t*)gate + (size_t)row * 1024 + (u.pn - 4) * BM;
                        *(u32x4*)(gd + bj * HALF + cw) = pack8(v0, v1); } }
        } else if (mode == M_UPF) {
            const int rowb = (u.pm - TOK / BM) * BM + wr * 64 + fr; const int pn0 = u.pn - 4;
#pragma unroll
            for (int ai = 0; ai < 2; ++ai) {
                u32x4 gm[4][2];
#pragma unroll
                for (int m = 0; m < 4; ++m) { const int row = rowb + ai * HALF + m * 16;
#pragma unroll
                    for (int bj = 0; bj < 2; ++bj) gm[m][bj] = *(const u32x4*)(gate + (size_t)row * 1024 + pn0 * BM + bj * HALF + cw); }
                asm volatile("" ::: "memory");
#pragma unroll
                for (int m = 0; m < 4; ++m) { const int row = rowb + ai * HALF + m * 16;
#pragma unroll
                    for (int bj = 0; bj < 2; ++bj) { f32x4 m0, m1; unpack8(gm[m][bj], m0, m1);
                        *(u32x4*)(b0 + (size_t)row * 1024 + pn0 * BM + bj * HALF + cw) = pack8(m0 * acc[ai][bj][m][0], m1 * acc[ai][bj][m][1]); } }
                asm volatile("" ::: "memory"); }
        } else {
#pragma unroll
            for (int ai = 0; ai < 2; ++ai) {
                u32x4 gw[4][2], pw[4][2];
#pragma unroll
                for (int m = 0; m < 4; ++m) { const int row = rowb + ai * HALF + m * 16;
#pragma unroll
                    for (int bj = 0; bj < 2; ++bj) { const int col = u.pn * BM + bj * HALF + cw; gw[m][bj] = *(const u32x4*)(gate + (size_t)row * 2048 + col);
                        if (mode == M_UPM) pw[m][bj] = *(const u32x4*)(b0 + (size_t)row * 1024 + col); } }
                asm volatile("" ::: "memory");
#pragma unroll
                for (int m = 0; m < 4; ++m) { const int row = rowb + ai * HALF + m * 16;
#pragma unroll
                    for (int bj = 0; bj < 2; ++bj) { const int col = u.pn * BM + bj * HALF + cw; f32x4 g0, g1; unpack8(gw[m][bj], g0, g1);
                        f32x4 y0 = g0 * acc[ai][bj][m][0], y1 = g1 * acc[ai][bj][m][1];
                        if (mode == M_UPM) { f32x4 p0, p1; unpack8(pw[m][bj], p0, p1); y0 += p0; y1 += p1; }
                        *(u32x4*)(b0 + (size_t)row * 1024 + col) = pack8(y0, y1); } }
                asm volatile("" ::: "memory"); }
        }
    }
};
template <class Epi, class Sched, bool ALIGN_EPI = false, bool SP2 = false>
__device__ __forceinline__ void gemm_phase(PG8_LAS unsigned char* lds, const Gemm g, const Sched& S, const Epi& E) {
    int tid_l = threadIdx.x; asm volatile("" : "+v"(tid_l)); const int tid = tid_l, wid = __builtin_amdgcn_readfirstlane(tid >> 6), lane = tid & 63, wr = wid >> 2, wc = wid & 3, fr = lane & 15, fq = lane >> 4;
    const int K = g.K, nt = K / BK;
    unsigned voffA[2], voffB[2];
#pragma unroll
    for (int i = 0; i < 2; ++i) { int R, C; stage_rc(tid * 16 + i * 8192, R, C); const int Rb = Epi::PERM ? ((R & ~31) + perm32(R & 31)) : R;
        voffA[i] = (unsigned)(R * K + C) * 2u; voffB[i] = (unsigned)(Rb * K + C) * 2u; }
    const size_t kstep = (size_t)(BK * 2);
    const size_t hstep = (size_t)HALF * K * 2;
    const size_t tstep = 2 * hstep;
    const unsigned ldsw = (unsigned)wid * 1024u;
    const int aoff = lds_byte(wr * 64 + fr, fq * 8), boff = lds_byte(wc * 32 + fr, fq * 8);
#define PG8_SA(b, h) (((b) * 2 + (h)) * HTB)
#define PG8_SB(b, h) ((4 + (b) * 2 + (h)) * HTB)
#define PG8_STAGE(bufoff, gbase, voff) do { _Pragma("unroll") for (int _i = 0; _i < 2; ++_i) \
        __builtin_amdgcn_global_load_lds((const unsigned*)((const char*)(gbase) + (voff)[_i]), (PG8_LAS unsigned*)(lds + (bufoff) + ldsw + _i * 8192), 16, 0, 0); } while (0)
#define PG8_LDA(dst, b, h) do { _Pragma("unroll") for (int m = 0; m < 4; ++m) _Pragma("unroll") for (int k = 0; k < 2; ++k) dst[m][k] = *(const PG8_LAS bf16x8*)(lds + PG8_SA(b, h) + aoff + m * 2048 + k * 1024); } while (0)
#define PG8_LDB(dst, b, h) do { _Pragma("unroll") for (int n = 0; n < 2; ++n) _Pragma("unroll") for (int k = 0; k < 2; ++k) dst[n][k] = *(const PG8_LAS bf16x8*)(lds + PG8_SB(b, h) + boff + n * 2048 + k * 1024); } while (0)
#define PG8_MMA(ai, bj, At, Bt) do { __builtin_amdgcn_s_setprio(1); _Pragma("unroll") for (int m = 0; m < 4; ++m) _Pragma("unroll") for (int n = 0; n < 2; ++n) _Pragma("unroll") for (int k = 0; k < 2; ++k) \
        acc[ai][bj][m][n] = __builtin_amdgcn_mfma_f32_16x16x32_bf16(Bt[n][k], At[m][k], acc[ai][bj][m][n], 0, 0, 0); __builtin_amdgcn_s_setprio(0); } while (0)
#define PG8_WAIT_V(n) asm volatile("s_waitcnt vmcnt(" #n ")" ::: "memory")
#define PG8_WAIT_L(n) asm volatile("s_waitcnt lgkmcnt(" #n ")" ::: "memory")
#define PG8_BAR __builtin_amdgcn_s_barrier()
#define PG8_SCHED __builtin_amdgcn_sched_barrier(0)
    Unit cur, nxt; int ui = 0;
    if (!S.next(0, cur)) return;
    f32x4 acc[2][2][4][2];
#pragma unroll
    for (int a = 0; a < 2; ++a)
#pragma unroll
        for (int b = 0; b < 2; ++b)
#pragma unroll
            for (int m = 0; m < 4; ++m)
#pragma unroll
                for (int n = 0; n < 2; ++n) acc[a][b][m][n] = (f32x4){0.f, 0.f, 0.f, 0.f};
    bf16x8 At[4][2], B0[2][2], B1[2][2];
    const char* cA = (const char*)g.A + (size_t)cur.pm * tstep; const char* cB = (const char*)g.Bt + (size_t)cur.pn * tstep;
    S.a_ready(cur);
    if constexpr (SP2) {
        PG8_STAGE(PG8_SB(0, 0), cB, voffB); PG8_STAGE(PG8_SB(0, 1), cB + hstep, voffB); PG8_STAGE(PG8_SA(0, 0), cA, voffA); PG8_STAGE(PG8_SA(0, 1), cA + hstep, voffA);
        if (wr == 1) PG8_BAR;
        PG8_WAIT_V(2); PG8_BAR;
        PG8_STAGE(PG8_SB(1, 0), cB + kstep, voffB); PG8_STAGE(PG8_SA(1, 0), cA + kstep, voffA); PG8_STAGE(PG8_SB(1, 1), cB + hstep + kstep, voffB);
        PG8_WAIT_V(6); PG8_BAR;
    } else {
        PG8_STAGE(PG8_SB(0, 0), cB, voffB); PG8_STAGE(PG8_SA(0, 0), cA, voffA); PG8_STAGE(PG8_SB(0, 1), cB + hstep, voffB); PG8_STAGE(PG8_SA(0, 1), cA + hstep, voffA);
        if (wr == 1) PG8_BAR;
        PG8_WAIT_V(4); PG8_BAR;
        PG8_STAGE(PG8_SB(1, 0), cB + kstep, voffB); PG8_STAGE(PG8_SA(1, 0), cA + kstep, voffA); PG8_STAGE(PG8_SB(1, 1), cB + hstep + kstep, voffB);
        PG8_WAIT_V(6); PG8_BAR;
    }
    for (;;) {
        const bool has_next = S.next(ui + 1, nxt);
        const char* nA = has_next ? (const char*)g.A + (size_t)nxt.pm * tstep : cA; const char* nB = has_next ? (const char*)g.Bt + (size_t)nxt.pn * tstep : cB;
        for (int t = 0; t < nt; t += 2) {
            const bool last = (t == nt - 2);
            const char* a1 = cA + (size_t)(t + 1) * kstep;
            const char* a2 = last ? nA : cA + (size_t)(t + 2) * kstep; const char* b2 = last ? nB : cB + (size_t)(t + 2) * kstep;
            const char* a3 = a2 + kstep; const char* b3 = b2 + kstep;
            if (last && has_next) S.a_ready(nxt);
            if constexpr (SP2) {
            PG8_LDB(B0, 0, 0); PG8_LDB(B1, 0, 1); PG8_SCHED; PG8_LDA(At, 0, 0); PG8_STAGE(PG8_SA(1, 1), a1 + hstep, voffA);
            PG8_WAIT_V(8); PG8_WAIT_L(0); PG8_BAR; PG8_MMA(0, 0, At, B0); PG8_MMA(0, 1, At, B1); PG8_BAR; PG8_SCHED;
            PG8_LDA(At, 0, 1); PG8_STAGE(PG8_SB(0, 0), b2, voffB); PG8_STAGE(PG8_SB(0, 1), b2 + hstep, voffB); PG8_STAGE(PG8_SA(0, 0), a2, voffA);
            PG8_WAIT_V(8); PG8_WAIT_L(0); PG8_BAR; PG8_MMA(1, 0, At, B0); PG8_MMA(1, 1, At, B1); PG8_BAR; PG8_SCHED;
            PG8_LDB(B0, 1, 0); PG8_LDB(B1, 1, 1); PG8_SCHED; PG8_LDA(At, 1, 0); PG8_STAGE(PG8_SA(0, 1), a2 + hstep, voffA);
            PG8_WAIT_V(8); PG8_WAIT_L(0); PG8_BAR; PG8_MMA(0, 0, At, B0); PG8_MMA(0, 1, At, B1); PG8_BAR; PG8_SCHED;
            PG8_LDA(At, 1, 1); PG8_STAGE(PG8_SB(1, 0), b3, voffB); PG8_STAGE(PG8_SB(1, 1), b3 + hstep, voffB); PG8_STAGE(PG8_SA(1, 0), a3, voffA);
            PG8_WAIT_V(8); PG8_WAIT_L(0); PG8_BAR; PG8_MMA(1, 0, At, B0); PG8_MMA(1, 1, At, B1); PG8_BAR; PG8_SCHED;
            } else {
            PG8_LDB(B0, 0, 0); PG8_SCHED; PG8_LDA(At, 0, 0); PG8_STAGE(PG8_SA(1, 1), a1 + hstep, voffA);
            PG8_WAIT_L(8); PG8_BAR; PG8_WAIT_L(0); PG8_MMA(0, 0, At, B0); PG8_BAR; PG8_SCHED;
            PG8_LDB(B1, 0, 1); PG8_STAGE(PG8_SB(0, 0), b2, voffB);
            PG8_BAR; PG8_WAIT_L(0); PG8_MMA(0, 1, At, B1); PG8_BAR;
            PG8_LDA(At, 0, 1); PG8_STAGE(PG8_SA(0, 0), a2, voffA);
            PG8_BAR; PG8_WAIT_L(0); PG8_MMA(1, 0, At, B0); PG8_BAR; PG8_SCHED;
            PG8_STAGE(PG8_SB(0, 1), b2 + hstep, voffB);
            PG8_WAIT_V(6); PG8_BAR; PG8_MMA(1, 1, At, B1); PG8_BAR;
            PG8_LDB(B0, 1, 0); PG8_SCHED; PG8_LDA(At, 1, 0); PG8_STAGE(PG8_SA(0, 1), a2 + hstep, voffA);
            PG8_WAIT_L(8); PG8_BAR; PG8_WAIT_L(0); PG8_MMA(0, 0, At, B0); PG8_BAR; PG8_SCHED;
            PG8_LDB(B1, 1, 1); PG8_STAGE(PG8_SB(1, 0), b3, voffB);
            PG8_BAR; PG8_WAIT_L(0); PG8_MMA(0, 1, At, B1); PG8_BAR;
            PG8_LDA(At, 1, 1); PG8_STAGE(PG8_SA(1, 0), a3, voffA);
            PG8_BAR; PG8_WAIT_L(0); PG8_MMA(1, 0, At, B0); PG8_BAR; PG8_SCHED;
            PG8_STAGE(PG8_SB(1, 1), b3 + hstep, voffB);
            PG8_WAIT_V(6); PG8_BAR; PG8_MMA(1, 1, At, B1); PG8_BAR;
            }
        }
        if constexpr (ALIGN_EPI) { if (wr == 0) PG8_BAR; }
        bool keep_acc = false;
        if constexpr (Epi::HAS_MID) { if (E.is_first_half(cur)) { E.mid(acc, cur, wr, wc, fr, fq); keep_acc = true; } else E(acc, cur, wr, wc, fr, fq); }
        else if constexpr (!Epi::AFTER_DRAIN) { E(acc, cur, wr, wc, fr, fq); S.done(cur); }
        if (!has_next) break;
        if (!keep_acc)
#pragma unroll
        for (int a = 0; a < 2; ++a)
#pragma unroll
            for (int b = 0; b < 2; ++b)
#pragma unroll
                for (int m = 0; m < 4; ++m)
#pragma unroll
                    for (int n = 0; n < 2; ++n) acc[a][b][m][n] = (f32x4){0.f, 0.f, 0.f, 0.f};
        cur = nxt; cA = nA; cB = nB; ++ui;
        if constexpr (ALIGN_EPI) { if (wr == 1) PG8_BAR; }
    }
    PG8_WAIT_V(0);
    if constexpr (!ALIGN_EPI) { if (wr == 0) PG8_BAR; }
    PG8_BAR;
    if constexpr (Epi::AFTER_DRAIN) { E.fused(acc, cur, wr, wc, fr, fq, lds, wid, lane); S.done(cur); }
#undef PG8_SA
#undef PG8_SB
#undef PG8_STAGE
#undef PG8_LDA
#undef PG8_LDB
#undef PG8_MMA
#undef PG8_WAIT_V
#undef PG8_WAIT_L
#undef PG8_BAR
#undef PG8_SCHED
}
}
#include <hip/hip_bf16.h>
#include <cmath>
namespace attn_body {
using bf16=__hip_bfloat16;
using bf16x8=__attribute__((ext_vector_type(8)))short;
using s16x4=__attribute__((ext_vector_type(4)))short;
using f32x16=__attribute__((ext_vector_type(16)))float;
using u32x4=__attribute__((ext_vector_type(4)))unsigned;
constexpr int BATCH=24,NHEAD=8,SEQ=2048,D=64,QP=512,KVP=256,OP=512;
constexpr int NW=8,QBLK=32,QB=QBLK*NW,KVBLK=64,NQB=SEQ/QB;
constexpr int ATTN_UNIT_ROWS=QB;
__device__ __forceinline__ int crow(int r,int hi){return (r&3)+8*(r>>2)+4*hi;}
#define SBAR() __builtin_amdgcn_sched_barrier(0)
__device__ __forceinline__ void cmask(f32x16&p0,f32x16&p1,int jb,int qrel,int hi){
  const float NEG=-INFINITY; int kb=64*jb+4*hi;
  #pragma unroll
  for(int r=0;r<16;++r){int kv=kb+(r&3)+8*(r>>2); if(kv>qrel)p0[r]=NEG; if(kv+32>qrel)p1[r]=NEG;}
}

constexpr int NSLOT=3, SLOTB=8192;
constexpr int LDS_K=0, LDS_V=NSLOT*SLOTB, LDS_WS=2*NSLOT*SLOTB, LDS_OST=LDS_WS+NW*64*4, LDS_BYTES=LDS_OST+NW*4096;
constexpr float C2=0.125f*1.4426950408889634f;
__device__ __forceinline__ void glds16(const void*gsrc,unsigned lds_dst){unsigned keep;
  asm volatile("s_mov_b32 %0, m0\n\ts_mov_b32 m0, %2\n\ts_nop 0\n\tglobal_load_lds_dwordx4 %1, off\n\ts_mov_b32 m0, %0":"=&s"(keep):"v"(gsrc),"s"(lds_dst):"memory");}
__device__ __forceinline__ float max3f(float a,float b,float c){float r;asm("v_max3_f32 %0, %1, %2, %3":"=v"(r):"v"(a),"v"(b),"v"(c));return r;}
__device__ __forceinline__ float max2f(float a,float b){float r;asm("v_max_f32_e32 %0, %1, %2":"=v"(r):"v"(a),"v"(b));return r;}
__device__ __forceinline__ float fadd_s(float a,float b){float r;asm("v_add_f32_e32 %0, %1, %2":"=v"(r):"v"(a),"v"(b));return r;}
__device__ __forceinline__ float fsub_s(float a,float b){float r;asm("v_sub_f32_e32 %0, %1, %2":"=v"(r):"v"(a),"v"(b));return r;}
typedef float f32x2_t __attribute__((ext_vector_type(2))); typedef __bf16 bf16x2_t __attribute__((ext_vector_type(2)));
__device__ __forceinline__ unsigned cvtpk_s(float lo,float hi){f32x2_t v={lo,hi};bf16x2_t b=__builtin_convertvector(v,bf16x2_t);return __builtin_bit_cast(unsigned,b);}
#define WAIT_BAR(N) asm volatile("s_waitcnt vmcnt(" #N ") lgkmcnt(0)\n\ts_barrier":::"memory")

__device__ __forceinline__ void qkt(f32x16&p0,f32x16&p1,const char*Kslot,const bf16x8*qr,const f32x16&negm,int r32,int hi){
  const char*kb=Kslot+hi*1024+r32*16;
  #pragma unroll
  for(int d0=0;d0<4;++d0){
    const bf16x8 b0=*reinterpret_cast<const bf16x8*>(kb+d0*2048);
    const bf16x8 b1=*reinterpret_cast<const bf16x8*>(kb+d0*2048+512);
    if(d0==0){p0=__builtin_amdgcn_mfma_f32_32x32x16_bf16(b0,qr[0],negm,0,0,0);p1=__builtin_amdgcn_mfma_f32_32x32x16_bf16(b1,qr[0],negm,0,0,0);}
    else{p0=__builtin_amdgcn_mfma_f32_32x32x16_bf16(b0,qr[d0],p0,0,0,0);p1=__builtin_amdgcn_mfma_f32_32x32x16_bf16(b1,qr[d0],p1,0,0,0);}}
}
typedef __attribute__((address_space(3))) const char* lds_cptr;
typedef short v4i16_t __attribute__((ext_vector_type(4)));
__device__ __forceinline__ void kload8(bf16x8*kf,lds_cptr kp){
  kf[0]=*(const __attribute__((address_space(3))) bf16x8*)(kp);      kf[1]=*(const __attribute__((address_space(3))) bf16x8*)(kp+512);
  kf[2]=*(const __attribute__((address_space(3))) bf16x8*)(kp+2048); kf[3]=*(const __attribute__((address_space(3))) bf16x8*)(kp+2560);
  kf[4]=*(const __attribute__((address_space(3))) bf16x8*)(kp+4096); kf[5]=*(const __attribute__((address_space(3))) bf16x8*)(kp+4608);
  kf[6]=*(const __attribute__((address_space(3))) bf16x8*)(kp+6144); kf[7]=*(const __attribute__((address_space(3))) bf16x8*)(kp+6656);
}
__device__ __forceinline__ void kload2(bf16x8*kf,lds_cptr kp,int j){ kf[2*j]=*(const __attribute__((address_space(3))) bf16x8*)(kp+j*2048); kf[2*j+1]=*(const __attribute__((address_space(3))) bf16x8*)(kp+j*2048+512); }
__device__ __forceinline__ s16x4 vtr(lds_cptr p){ return __builtin_bit_cast(s16x4,__builtin_amdgcn_ds_read_tr16_b64_v4i16((__attribute__((address_space(3))) v4i16_t*)p)); }
__device__ __forceinline__ float rowmax(const f32x16&p0,const f32x16&p1){
  float a=max3f(p0[0],p0[1],p1[0]),b=max3f(p0[2],p0[3],p1[1]);a=max3f(a,p1[2],p1[3]);
  #pragma unroll
  for(int r=4;r<16;r+=4){a=max3f(a,p0[r],p0[r+1]);b=max3f(b,p0[r+2],p0[r+3]);a=max3f(a,p1[r],p1[r+1]);b=max3f(b,p1[r+2],p1[r+3]);}
  const float m=max2f(a,b);
  auto rr=__builtin_amdgcn_permlane32_swap(__float_as_uint(m),__float_as_uint(m),false,false);
  return max2f(__uint_as_float(rr[0]),__uint_as_float(rr[1]));
}
__device__ __forceinline__ void pv(f32x16*o,int vb,bf16x8 pa0,bf16x8 pa1,bf16x8 pa2,bf16x8 pa3){
  #pragma unroll
  for(int d0=0;d0<2;++d0){s16x4 lo[4],hi[4];
    #pragma unroll
    for(int ks=0;ks<4;++ks){
      asm volatile("ds_read_b64_tr_b16 %0,%1 offset:%c2":"=&v"(lo[ks]):"v"(vb),"i"(d0*4096+ks*1024):"memory");
      asm volatile("ds_read_b64_tr_b16 %0,%1 offset:%c2":"=&v"(hi[ks]):"v"(vb),"i"(d0*4096+ks*1024+512):"memory");}
    asm volatile("s_waitcnt lgkmcnt(0)":::"memory");SBAR();
    #define PK(k) (bf16x8){lo[k][0],lo[k][1],lo[k][2],lo[k][3],hi[k][0],hi[k][1],hi[k][2],hi[k][3]}
    o[d0]=__builtin_amdgcn_mfma_f32_32x32x16_bf16(pa0,PK(0),o[d0],0,0,0);
    o[d0]=__builtin_amdgcn_mfma_f32_32x32x16_bf16(pa1,PK(1),o[d0],0,0,0);
    o[d0]=__builtin_amdgcn_mfma_f32_32x32x16_bf16(pa2,PK(2),o[d0],0,0,0);
    o[d0]=__builtin_amdgcn_mfma_f32_32x32x16_bf16(pa3,PK(3),o[d0],0,0,0);
    #undef PK
  }
}

#ifndef ATTN_STORE16
#define ATTN_STORE16(p,v) (*(u32x4*)(p)=(v))
#endif
template<int THRL> __device__ __forceinline__ void attn_unit(int b,int h,int qb,const bf16*Q,const bf16*__restrict__ K,const bf16*__restrict__ V,bf16*O,char*shm){
  int tid_l=threadIdx.x; asm volatile("":"+v"(tid_l)); const int tid=tid_l,lane=tid&63,r32=lane&31,hi=lane>>5; const int wid=__builtin_amdgcn_readfirstlane(tid>>6);
  const long rowbase=(long)b*SEQ; const int q0=qb*QB;
  const bf16*Qw=Q+(rowbase+q0+wid*QBLK)*QP+h*D;
  const bf16*Kh=K+rowbase*KVP+(h>>2)*D,*Vh=V+rowbase*KVP+(h>>2)*D;
  const unsigned lds0=(unsigned)(uintptr_t)shm;
  float*wsf=(float*)(shm+LDS_WS)+wid*64;
  const bf16*ksrc=Kh+(long)lane*KVP+wid*8;
  const bf16*vsrc=Vh+(long)(16*(wid&3)+(lane>>2))*KVP+(wid>>2)*32+(lane&3)*8;
  const unsigned kdst=lds0+LDS_K+wid*1024, vdst=lds0+LDS_V+wid*1024;
  #define DMA_K(t,slot) glds16(ksrc+(long)(t)*KVBLK*KVP,(unsigned)__builtin_amdgcn_readfirstlane(kdst+(slot)))
  #define DMA_V(t,slot) glds16(vsrc+(long)(t)*KVBLK*KVP,(unsigned)__builtin_amdgcn_readfirstlane(vdst+(slot)))
  const int vb0=(int)(lds0+LDS_V)+((lane>>4)&1)*32+(lane&3)*8+(4*hi+((lane&15)>>2))*64;
  const char*Kbase=shm+LDS_K; bf16x8 kf[8];
  const lds_cptr shm3=(lds_cptr)shm; const lds_cptr kp0=shm3+LDS_K+hi*1024+r32*16; const lds_cptr vp0=shm3+LDS_V+((lane>>4)&1)*32+(lane&3)*8+(4*hi+((lane&15)>>2))*64;
  const int NT=SEQ/KVBLK;
  DMA_K(0,0);DMA_V(0,0);DMA_K(1,SLOTB);
  bf16x8 qr[4];
  #pragma unroll
  for(int d0=0;d0<4;++d0)qr[d0]=*reinterpret_cast<const bf16x8*>(&Qw[(long)r32*QP+d0*16+hi*8]);
  float mhat=0.f,l_reg=0.f;f32x16 o[2];o[0]=f32x16{};o[1]=f32x16{};f32x16 negm=f32x16{};asm volatile("":"+v"(negm));
  const int qrel=wid*QBLK+r32;
  #define CMASK(P0,P1,t) do{}while(0)
  bool resc=false;
  #define START(P0,P1) do{ const float rm=rowmax(P0,P1); resc=false; \
    { const float dl=rm; mhat=fadd_s(mhat,dl); \
      _Pragma("unroll") for(int r=0;r<16;++r){P0[r]=fsub_s(P0[r],dl);P1[r]=fsub_s(P1[r],dl);} \
      _Pragma("unroll") for(int r=0;r<16;++r)negm[r]=-mhat; asm volatile("":"+v"(negm)); } \
    _Pragma("unroll") for(int r=0;r<16;++r)P0[r]=__builtin_amdgcn_exp2f(P0[r]); }while(0)
  #define RESC() do{ if(resc){ asm volatile("s_waitcnt lgkmcnt(0)":::"memory"); \
      _Pragma("unroll") for(int d_=0;d_<2;++d_) _Pragma("unroll") for(int r=0;r<16;++r)o[d_][r]*=wsf[crow(r,hi)]; } }while(0)
  f32x16 pA0,pA1,pB0,pB1;
  int sl_prev=0,sl_cur=0,sl_next=SLOTB;
  #define ROT() do{sl_prev=sl_cur;sl_cur=sl_next;sl_next=(sl_next==(NSLOT-1)*SLOTB)?0:sl_next+SLOTB;}while(0)
  DMA_K(2,2*SLOTB);
  WAIT_BAR(3);
  qkt(pA0,pA1,Kbase,qr,negm,r32,hi);asm volatile("s_nop 15\n\ts_nop 7":"+v"(pA0),"+v"(pA1));CMASK(pA0,pA1,0);
  START(pA0,pA1);
  _Pragma("unroll") for(int r=0;r<16;++r)pA1[r]=__builtin_amdgcn_exp2f(pA1[r]);
  WAIT_BAR(0);
  DMA_K(3,0);DMA_V(1,SLOTB);
  ROT();
  kload8(kf,kp0+sl_cur);
  WAIT_BAR(2);
  s16x4 vlo[8],vhi[8]; u32x4 pw0,pw1,pw2,pw3;
  #define PKW(P,B) cvtpk_s(P[B],P[B+1])
  #define PAF(k) __builtin_bit_cast(bf16x8,pw##k)
  #define VFR(i) (bf16x8){vlo[i][0],vlo[i][1],vlo[i][2],vlo[i][3],vhi[i][0],vhi[i][1],vhi[i][2],vhi[i][3]}
  #define PIN(x) asm volatile("":"+v"(x))
  #define MX3(a,b,c) __builtin_fmaxf(__builtin_fmaxf((a),(b)),(c))
  #define GAPA(MF,A0,A1,A2,A3,W0,W1,PW) do{ MF; sacc+=A0; sacc+=A1; sacc+=A2; sacc+=A3; PIN(sacc); W0; W1; PIN(PW); SBAR(); }while(0)
  #define EX(v) __builtin_amdgcn_exp2f(v)
  #define GAPB(MF,X,B) do{ MF; X[B]=EX(X[B]); X[B+1]=EX(X[B+1]); X[B+2]=EX(X[B+2]); X[B+3]=EX(X[B+3]); PIN(X); SBAR(); }while(0)
  #define VRD(i) do{ vlo[i]=vtr(vp_+(((i)>>2)*4096+((i)&3)*1024)); vhi[i]=vtr(vp_+(((i)>>2)*4096+((i)&3)*1024+512)); }while(0)
  #define KRD(G,j) do{ if(G){ kload2(kf,kp0+sl_next,j); SBAR(); } }while(0)
  #define STEP(C0,C1,P0,P1,t,GK,GV,GL) do{ SBAR(); \
    const lds_cptr vp_=vp0+sl_prev; \
    VRD(0); SBAR(); float sacc=(P0[0]+P0[1]); \
    GAPA(C0=__builtin_amdgcn_mfma_f32_32x32x16_bf16(kf[0],qr[0],negm,0,0,0), P0[2],P0[3],P0[4],P0[5],     pw0[0]=PKW(P0,0), pw0[1]=PKW(P0,2), pw0); \
    VRD(4); SBAR(); GAPA(C1=__builtin_amdgcn_mfma_f32_32x32x16_bf16(kf[1],qr[0],negm,0,0,0), P0[6],P0[7],P0[8],P0[9],     pw0[2]=PKW(P0,4), pw0[3]=PKW(P0,6), pw0); \
    VRD(1); SBAR(); GAPA(C0=__builtin_amdgcn_mfma_f32_32x32x16_bf16(kf[2],qr[1],C0,0,0,0),   P0[10],P0[11],P0[12],P0[13], pw1[0]=PKW(P0,8), pw1[1]=PKW(P0,10), pw1); \
    VRD(5); SBAR(); GAPA(C1=__builtin_amdgcn_mfma_f32_32x32x16_bf16(kf[3],qr[1],C1,0,0,0),   P0[14],P0[15],P1[0],P1[1],   pw1[2]=PKW(P0,12),pw1[3]=PKW(P0,14), pw1); \
    VRD(2); SBAR(); GAPA(C0=__builtin_amdgcn_mfma_f32_32x32x16_bf16(kf[4],qr[2],C0,0,0,0),   P1[2],P1[3],P1[4],P1[5],     pw2[0]=PKW(P1,0), pw2[1]=PKW(P1,2), pw2); \
    VRD(6); SBAR(); GAPA(C1=__builtin_amdgcn_mfma_f32_32x32x16_bf16(kf[5],qr[2],C1,0,0,0),   P1[6],P1[7],P1[8],P1[9],     pw2[2]=PKW(P1,4), pw2[3]=PKW(P1,6), pw2); \
    VRD(3); SBAR(); GAPA(C0=__builtin_amdgcn_mfma_f32_32x32x16_bf16(kf[6],qr[3],C0,0,0,0),   P1[10],P1[11],P1[12],P1[13], pw3[0]=PKW(P1,8), pw3[1]=PKW(P1,10), pw3); \
    VRD(7); SBAR(); GAPA(C1=__builtin_amdgcn_mfma_f32_32x32x16_bf16(kf[7],qr[3],C1,0,0,0),   P1[14],P1[15],0.f,0.f,       pw3[2]=PKW(P1,12),pw3[3]=PKW(P1,14), pw3); \
    l_reg+=sacc; \
    if(GK){DMA_K((t)+3,sl_cur);} if(GV){DMA_V((t)+1,sl_next);} \
    CMASK(C0,C1,t); \
    { float a=MX3(C0[0],C0[1],C1[0]),b=MX3(C0[2],C0[3],C1[1]); a=MX3(a,C1[2],C1[3]); \
      _Pragma("unroll") for(int r=4;r<16;r+=4){a=MX3(a,C0[r],C0[r+1]);b=MX3(b,C0[r+2],C0[r+3]);a=MX3(a,C1[r],C1[r+1]);b=MX3(b,C1[r+2],C1[r+3]);} \
      float rm=__builtin_fmaxf(a,b); { auto rr=__builtin_amdgcn_permlane32_swap(__float_as_uint(rm),__float_as_uint(rm),false,false); rm=__builtin_fmaxf(__uint_as_float(rr[0]),__uint_as_float(rr[1])); } \
      resc=false; \
      if(__builtin_expect(__any(rm>(float)THRL),0)){ const float dl=__builtin_fmaxf(rm,0.f); mhat+=dl; \
        _Pragma("unroll") for(int r=0;r<16;++r){C0[r]-=dl;C1[r]-=dl;} \
        _Pragma("unroll") for(int r=0;r<16;++r)negm[r]=-mhat; asm volatile("":"+v"(negm)); \
        const float f=__builtin_amdgcn_exp2f(-dl); l_reg*=f; if(hi==0)wsf[r32]=f; resc=true; } } \
    SBAR(); \
    GAPB(o[0]=__builtin_amdgcn_mfma_f32_32x32x16_bf16(PAF(0),VFR(0),o[0],0,0,0), C0,0); \
    GAPB(o[1]=__builtin_amdgcn_mfma_f32_32x32x16_bf16(PAF(0),VFR(4),o[1],0,0,0), C0,4); \
    KRD(GL,0); GAPB(o[0]=__builtin_amdgcn_mfma_f32_32x32x16_bf16(PAF(1),VFR(1),o[0],0,0,0), C0,8); \
    KRD(GL,1); GAPB(o[1]=__builtin_amdgcn_mfma_f32_32x32x16_bf16(PAF(1),VFR(5),o[1],0,0,0), C0,12); \
    KRD(GL,2); GAPB(o[0]=__builtin_amdgcn_mfma_f32_32x32x16_bf16(PAF(2),VFR(2),o[0],0,0,0), C1,0); \
    KRD(GL,3); GAPB(o[1]=__builtin_amdgcn_mfma_f32_32x32x16_bf16(PAF(2),VFR(6),o[1],0,0,0), C1,4); \
    GAPB(o[0]=__builtin_amdgcn_mfma_f32_32x32x16_bf16(PAF(3),VFR(3),o[0],0,0,0), C1,8); \
    GAPB(o[1]=__builtin_amdgcn_mfma_f32_32x32x16_bf16(PAF(3),VFR(7),o[1],0,0,0), C1,12); \
    }while(0)
  int t=1;
  #undef CMASK
  #define CMASK(P0,P1,t) do{}while(0)
  for(;t+5<NT;t+=2){
    STEP(pB0,pB1,pA0,pA1,t,true,true,true);     WAIT_BAR(2); RESC(); ROT();
    STEP(pA0,pA1,pB0,pB1,t+1,true,true,true);   WAIT_BAR(2); RESC(); ROT();
  }
  #undef CMASK
  #define CMASK(P0,P1,t) do{}while(0)
  #define ENDW(tt) do{ if((tt)+3<NT){WAIT_BAR(2);} else if((tt)+2<NT){WAIT_BAR(1);} else {WAIT_BAR(0);} }while(0)
  for(;t+1<NT;t+=2){
    STEP(pB0,pB1,pA0,pA1,t,(t+3<NT),(t+1<NT),(t+1<NT));       ENDW(t);   RESC(); ROT();
    STEP(pA0,pA1,pB0,pB1,t+1,(t+4<NT),(t+2<NT),(t+2<NT));     ENDW(t+1); RESC(); ROT();
  }
  STEP(pB0,pB1,pA0,pA1,NT-1,false,false,false); RESC();
  { float sacc=pB0[0]+pB0[1]; _Pragma("unroll") for(int r=2;r<16;++r)sacc+=pB0[r]; _Pragma("unroll") for(int r=0;r<16;++r)sacc+=pB1[r]; l_reg+=sacc;
    pw0=(u32x4){PKW(pB0,0),PKW(pB0,2),PKW(pB0,4),PKW(pB0,6)};pw1=(u32x4){PKW(pB0,8),PKW(pB0,10),PKW(pB0,12),PKW(pB0,14)};pw2=(u32x4){PKW(pB1,0),PKW(pB1,2),PKW(pB1,4),PKW(pB1,6)};pw3=(u32x4){PKW(pB1,8),PKW(pB1,10),PKW(pB1,12),PKW(pB1,14)};
    SBAR(); pv(o,vb0+sl_cur,PAF(0),PAF(1),PAF(2),PAF(3)); }
  #undef PKW
  #undef PAF
  #undef VFR
  #undef PIN
  #undef MX3
  #undef GAPA
  #undef GAPB
  #undef EX
  #undef VRD
  #undef KRD
  #undef STEP
  #undef ENDW
  {auto rr=__builtin_amdgcn_permlane32_swap(__float_as_uint(l_reg),__float_as_uint(l_reg),false,false);l_reg=__uint_as_float(rr[0])+__uint_as_float(rr[1]);}
  if(hi==0)wsf[32+r32]=l_reg;asm volatile("s_waitcnt lgkmcnt(0)":::"memory");
  float rli[16];
  #pragma unroll
  for(int r=0;r<16;++r)rli[r]=__builtin_amdgcn_rcpf(wsf[32+crow(r,hi)]);
  bf16*Ow=O+(rowbase+q0+wid*QBLK)*OP+h*D;
  { bf16*stg=(bf16*)(shm+LDS_OST)+wid*2048;
    #pragma unroll
    for(int r=0;r<16;++r){const int orow=crow(r,hi);
      #pragma unroll
      for(int d0=0;d0<2;++d0)stg[orow*64+d0*32+r32]=__float2bfloat16(o[d0][r]*rli[r]);}
    asm volatile("s_waitcnt lgkmcnt(0)":::"memory");
    #pragma unroll
    for(int i=0;i<4;++i){const int row=i*8+(lane>>3),ch=lane&7; const u32x4 v=*(const u32x4*)(stg+row*64+ch*8); ATTN_STORE16(Ow+(long)row*OP+ch*8,v);} }
  asm volatile("s_waitcnt lgkmcnt(0)\n\ts_barrier":::"memory");
  #undef DMA_K
  #undef DMA_V
  #undef CMASK
  #undef START
  #undef RESC
  #undef ROT
}
constexpr int ATTN_LDS_BYTES=LDS_BYTES;
#undef SBAR
#undef WAIT_BAR
}
namespace cg = cooperative_groups;
#define GAS __attribute__((address_space(1)))
#define LAS __attribute__((address_space(3)))
typedef unsigned short bf16;
typedef unsigned v4u __attribute__((ext_vector_type(4)));
typedef unsigned v2u __attribute__((ext_vector_type(2)));
typedef float f32x4 __attribute__((ext_vector_type(4)));
typedef float f32x16 __attribute__((ext_vector_type(16)));
typedef short bf16x8 __attribute__((ext_vector_type(8)));
constexpr int NWAVES = 8;
constexpr int T = 49152, SEQ = 2048, NB = 24, DM = 1024, DFF = 2816, DIN = 4880;
constexpr float EPS = 1e-6f, LOG2E = 1.4426950408889634f;
constexpr size_t MiB = 1u << 20;
constexpr size_t WS_CTL = 0, CTL_ZERO_BYTES = 65536;
constexpr int CW_BAR = 4096;
constexpr size_t WS_ROPEC = 1 * MiB, WS_ROPES = WS_ROPEC + 256 * 1024;
constexpr size_t WS_SS0 = 1 * MiB + 512 * 1024, WS_SS1 = WS_SS0 + 256 * 1024, WS_SS2 = WS_SS1 + 256 * 1024, WS_SS3 = WS_SS2 + 256 * 1024;
constexpr size_t WS_WOLD = 2 * MiB + 512 * 1024;
constexpr size_t WS_G16 = 3 * MiB, WS_SC = 6 * MiB, WS_DEN = 14 * MiB;
constexpr size_t WS_W1GU = 16 * MiB, WS_W1D = 27 * MiB, WS_WIN = 33 * MiB, WS_WA = 43 * MiB, WS_WM = 44 * MiB, WS_WOUT = 45 * MiB, WS_W2GU = 47 * MiB, WS_W2D = 58 * MiB;
constexpr size_t WS_XB = 64 * MiB, WS_H = 160 * MiB;
constexpr size_t WS_QB = 160 * MiB, WS_KV = 208 * MiB, WS_MQK = 232 * MiB, WS_NUM = 328 * MiB, WS_OPRE = 424 * MiB, WS_MEM = 232 * MiB, WS_MERGED = 328 * MiB, WS_SCF = 472 * MiB, WS_END = 480 * MiB;
constexpr size_t OUT_AM = 96 * MiB, WS_GA = 160 * MiB;
constexpr int RING_BYTES = 131072, MISC_OFF = 140288, LDS_BYTES = 147456;
constexpr int ML_BUF = 66560;
constexpr int N_MLSTM_BLK = 192, N_ATT_UNITS = 1536;

struct Args { const float* in[20]; float* out; unsigned char* ws; };

__device__ __forceinline__ unsigned f2bf(float f) { unsigned u = __builtin_bit_cast(unsigned, f); return (u + 0x7fffu + ((u >> 16) & 1u)) >> 16; }
__device__ __forceinline__ unsigned pk2(float lo, float hi) { return f2bf(lo) | (f2bf(hi) << 16); }
__device__ __forceinline__ float bflo(unsigned w) { return __uint_as_float(w << 16); }
__device__ __forceinline__ float bfhi(unsigned w) { return __uint_as_float(w & 0xffff0000u); }
__device__ __forceinline__ float wave_sum(float v) {
#pragma unroll
    for (int o = 1; o < 64; o <<= 1) v += __shfl_xor(v, o);
    return v;
}
#define LDS_WAIT() asm volatile("s_waitcnt lgkmcnt(0)" ::: "memory")

struct Seg { const float* W; int ldw, K, c0, nc; bf16* dst; int drow0; const float* gain; float cs; int map; int ldk, koff; };
__device__ __forceinline__ int seg_items(const Seg& s) { return (s.K / 64) * ((s.nc + 31) / 32); }
__device__ __forceinline__ Seg get_seg(int i, const Args& a) {
    unsigned char* ws = a.ws; Seg s; s.gain = nullptr; s.cs = 1.f; s.map = 0; s.c0 = 0; s.drow0 = 0; s.ldk = 0; s.koff = 0;
    bf16* WIN = (bf16*)(ws + WS_WIN);
    switch (i) {
    case 0: s.W = a.in[3]; s.ldw = DFF; s.K = DM; s.nc = DFF; s.dst = (bf16*)(ws + WS_W1GU); s.gain = a.in[2]; s.map = 1; break;
    case 1: s.W = a.in[4]; s.ldw = DFF; s.K = DM; s.nc = DFF; s.dst = (bf16*)(ws + WS_W1GU); s.drow0 = 128; s.gain = a.in[2]; s.map = 1; break;
    case 2: s.W = a.in[5]; s.ldw = DM; s.K = DFF; s.nc = DM; s.dst = (bf16*)(ws + WS_W1D); s.cs = 0.5f; break;
    case 3: s.W = a.in[16]; s.ldw = DFF; s.K = DM; s.nc = DFF; s.dst = (bf16*)(ws + WS_W2GU); s.gain = a.in[15]; s.map = 1; break;
    case 4: s.W = a.in[17]; s.ldw = DFF; s.K = DM; s.nc = DFF; s.dst = (bf16*)(ws + WS_W2GU); s.drow0 = 128; s.gain = a.in[15]; s.map = 1; break;
    case 5: s.W = a.in[18]; s.ldw = DM; s.K = DFF; s.nc = DM; s.dst = (bf16*)(ws + WS_W2D); s.cs = 0.5f; break;
    case 6: s.W = a.in[7]; s.ldw = DIN; s.K = DM; s.c0 = 0; s.nc = 512; s.dst = WIN; s.drow0 = 0; s.gain = a.in[6]; s.map = 2; break;
    case 7: s.W = a.in[7]; s.ldw = DIN; s.K = DM; s.c0 = 512; s.nc = 128; s.dst = WIN; s.drow0 = 512; s.gain = a.in[6]; s.map = 3; break;
    case 8: s.W = a.in[7]; s.ldw = DIN; s.K = DM; s.c0 = 640; s.nc = 128; s.dst = WIN; s.drow0 = 512; s.gain = a.in[6]; s.map = 4; break;
    case 9: s.W = a.in[7]; s.ldw = DIN; s.K = DM; s.c0 = 768; s.nc = 512; s.dst = WIN; s.drow0 = 768; s.gain = a.in[6]; break;
    case 10: s.W = a.in[7]; s.ldw = DIN; s.K = DM; s.c0 = 2304; s.nc = 16; s.dst = WIN; s.drow0 = 1280; s.gain = a.in[6]; break;
    case 11: s.W = a.in[7]; s.ldw = DIN; s.K = DM; s.c0 = 2320; s.nc = 512; s.dst = WIN; s.drow0 = 1536; s.gain = a.in[6]; break;
    case 12: s.W = a.in[7]; s.ldw = DIN; s.K = DM; s.c0 = 1280; s.nc = 512; s.dst = WIN; s.drow0 = 2048; s.gain = a.in[6]; s.cs = 0.08838834764831845f; break;
    case 13: s.W = a.in[7]; s.ldw = DIN; s.K = DM; s.c0 = 1792; s.nc = 512; s.dst = WIN; s.drow0 = 2560; s.gain = a.in[6]; break;
    case 14: s.W = a.in[7]; s.ldw = DIN; s.K = DM; s.c0 = 2832; s.nc = 1024; s.dst = WIN; s.drow0 = 3072; s.gain = a.in[6]; break;
    case 15: s.W = a.in[7]; s.ldw = DIN; s.K = DM; s.c0 = 3856; s.nc = 1024; s.dst = WIN; s.drow0 = 4096; s.gain = a.in[6]; break;
    case 16: s.W = a.in[12]; s.ldw = DM; s.K = 512; s.nc = DM; s.dst = (bf16*)(ws + WS_WA); break;
    case 17: s.W = a.in[13]; s.ldw = DM; s.K = 512; s.nc = DM; s.dst = (bf16*)(ws + WS_WM); break;
    default: s.W = a.in[14]; s.ldw = DM; s.K = DM; s.nc = DM; s.dst = (bf16*)(ws + WS_WOUT); break;
    }
    if (s.ldk == 0) s.ldk = s.K;
    return s;
}
constexpr int NSEG = 19;
__device__ __forceinline__ void tr_item(const Seg& s, int item, LAS float* scr, int lane) {
    const int nblk = (s.nc + 31) / 32, kb = item / nblk, nb = item % nblk, k0 = 64 * kb, cb = 32 * nb;
    const int nv = (s.nc - cb) < 32 ? (s.nc - cb) : 32;
    const int c = lane & 31, c8 = lane & 7;
    float v[32];
    const float* src = s.W + (size_t)(k0 + (lane >> 5)) * s.ldw + s.c0 + cb + (c < nv ? c : 0);
#pragma unroll
    for (int i = 0; i < 32; ++i) v[i] = src[(size_t)(2 * i) * s.ldw];
    f32x4 g0 = (f32x4){1.f, 1.f, 1.f, 1.f}, g1 = g0;
    if (s.gain) { g0 = *(const f32x4*)(s.gain + k0 + 8 * c8); g1 = *(const f32x4*)(s.gain + k0 + 8 * c8 + 4); }
    g0 = g0 * s.cs; g1 = g1 * s.cs;
#pragma unroll
    for (int i = 0; i < 32; ++i) scr[(2 * i + (lane >> 5)) * 33 + c] = v[i];
    LDS_WAIT(); asm volatile("" ::: "memory");
    int drow = s.drow0 + cb;
    if (s.map == 1) drow = s.drow0 + 256 * (cb / 128) + (cb % 128);
    else if (s.map == 2) drow = (cb >> 8) * 256 + ((cb & 63) >> 5) * 128 + ((cb >> 6) & 3) * 32;
    else if (s.map == 3) drow = 512 + ((cb & 63) >> 5) * 128 + (cb >> 6) * 32;
    else if (s.map == 4) drow = 512 + (cb < 64 ? 64 + cb : 192 + (cb - 64));
#pragma unroll
    for (int j = 0; j < 4; ++j) { const int n = (lane >> 3) + 8 * j; const LAS float* sp = scr + (8 * c8) * 33 + n;
        v4u o; o.x = pk2(sp[0 * 33] * g0[0], sp[1 * 33] * g0[1]); o.y = pk2(sp[2 * 33] * g0[2], sp[3 * 33] * g0[3]); o.z = pk2(sp[4 * 33] * g1[0], sp[5 * 33] * g1[1]); o.w = pk2(sp[6 * 33] * g1[2], sp[7 * 33] * g1[3]);
        if (n < nv) *(v4u*)(s.dst + (size_t)(drow + n) * s.ldk + s.koff + k0 + 8 * c8) = o; }
    LDS_WAIT(); asm volatile("" ::: "memory");
}
__device__ __forceinline__ void p0_prologue(const Args& a, LAS unsigned char* lds, int gw, int NGW, int wave, int lane_in) {
    int lane = lane_in; asm volatile("" : "+v"(lane));
    LAS float* scr = (LAS float*)(lds + wave * 16384);
    int total = 0;
    for (int i = 0; i < NSEG; ++i) { const Seg s = get_seg(i, a); total += seg_items(s); }
    for (int it = gw; it < total; it += NGW) {
        int r = it, si = 0; Seg s = get_seg(0, a);
        for (;;) { const int n = seg_items(s); if (r < n) break; r -= n; ++si; s = get_seg(si, a); }
        tr_item(s, r, scr, lane);
    }
    { v4u* z = (v4u*)((bf16*)(a.ws + WS_WIN) + (size_t)1296 * DM); const int n16 = 240 * DM * 2 / 16;
      for (int i = gw * 64 + lane; i < n16; i += NGW * 64) z[i] = (v4u){0u, 0u, 0u, 0u}; }
    { float* rc = (float*)(a.ws + WS_ROPEC); float* rs = (float*)(a.ws + WS_ROPES);
      for (int i = gw * 64 + lane; i < SEQ * 32; i += NGW * 64) { const int pos = i >> 5, j = i & 31; const float invf = powf(10000.0f, -(float)(2 * (j & 15)) / 32.0f);
          const float ang = (float)(j < 16 ? (pos >> 6) : (pos & 63)) * invf; float sn, cs; sincosf(ang, &sn, &cs); rc[i] = cs; rs[i] = sn; } }
    bf16* XB = (bf16*)(a.ws + WS_XB); float* SS0 = (float*)(a.ws + WS_SS0); float* SS1 = (float*)(a.ws + WS_SS1); float* SS2 = (float*)(a.ws + WS_SS2); float* SS3 = (float*)(a.ws + WS_SS3);
    for (int m0 = gw * 2; m0 < T; m0 += NGW * 2) {
        f32x4 v[2][4]; float s[2];
#pragma unroll
        for (int r = 0; r < 2; ++r) { const int m = m0 + r; const float* xrow = (m < 16384 ? a.in[0] + (size_t)m * DM : a.in[1] + (size_t)(m - 16384) * DM);
            const f32x4* xr = (const f32x4*)xrow + lane;
#pragma unroll
            for (int j = 0; j < 4; ++j) v[r][j] = xr[64 * j]; }
#pragma unroll
        for (int r = 0; r < 2; ++r) { const int m = m0 + r; float ss = 0.f;
#pragma unroll
            for (int j = 0; j < 4; ++j) ss += (v[r][j].x * v[r][j].x + v[r][j].y * v[r][j].y) + (v[r][j].z * v[r][j].z + v[r][j].w * v[r][j].w);
            s[r] = wave_sum(ss);
            v2u* o8 = (v2u*)(XB + (size_t)m * DM) + lane;
#pragma unroll
            for (int j = 0; j < 4; ++j) o8[64 * j] = (v2u){pk2(v[r][j].x, v[r][j].y), pk2(v[r][j].z, v[r][j].w)};
            if (lane == 0) { SS0[m] = s[r]; SS1[m] = 0.f; SS2[m] = 0.f; SS3[m] = 0.f; } }
    }
}

__device__ __forceinline__ float logsigmoid(float x) { return fminf(x, 0.f) - log1pf(expf(-fabsf(x))); }
__device__ __forceinline__ void gate_scan_item(const Args& a, int item, int lane) {
    unsigned char* ws = a.ws;
    const float* G16 = (const float*)(ws + WS_G16); const float* bias = a.in[10];
    float* SC = (float*)(ws + WS_SC); float* WOLD = (float*)(ws + WS_WOLD);
    {
        const int dir = item & 1, h = (item >> 1) & 3, b = item >> 3;
        const float bi = bias[(2 * dir) * 4 + h], bf_ = bias[(2 * dir + 1) * 4 + h];
        float* sc = SC + (size_t)item * 5 * SEQ;
        float mrun = 0.f;
        float liv[32], lfv[32];
#pragma unroll
        for (int c = 0; c < 32; ++c) { const int t = dir ? (SEQ - 1 - (64 * c + lane)) : (64 * c + lane); const float* g = G16 + (size_t)(b * SEQ + t) * 16;
            liv[c] = g[(2 * dir) * 4 + h]; lfv[c] = g[(2 * dir + 1) * 4 + h]; }
#pragma unroll
        for (int c = 0; c < 32; ++c) {
            const int t = dir ? (SEQ - 1 - (64 * c + lane)) : (64 * c + lane);
            const float li = liv[c] + bi; const float lf = logsigmoid(lfv[c] + bf_);
            float bj = lf;
#pragma unroll
            for (int o = 1; o < 64; o <<= 1) { const float n = __shfl_up(bj, o); if (lane >= o) bj += n; }
            const float av = li - bj; float pm = av;
#pragma unroll
            for (int o = 1; o < 64; o <<= 1) { const float n = __shfl_up(pm, o); if (lane >= o) pm = fmaxf(pm, n); }
            const float Mx = fmaxf(mrun, pm);
            const float Mc = __shfl(Mx, 63), bL = __shfl(bj, 63);
            sc[0 * SEQ + t] = expf(Mc - Mx); sc[1 * SEQ + t] = Mx * LOG2E; sc[2 * SEQ + t] = expf(mrun - Mx); sc[3 * SEQ + t] = expf(-(bj + Mx)); sc[4 * SEQ + t] = expf(av - Mc);
            if (lane == 0) WOLD[item * 32 + c] = expf(mrun - Mc);
            { float* scf = (float*)(ws + WS_SCF) + (size_t)(item * 32 + (t >> 6)) * 256 + (t & 63);
              scf[0] = expf(Mc - Mx); scf[64] = expf(mrun - Mx); scf[128] = expf(av - Mc); scf[192] = expf(mrun - Mc); }
            mrun = bL + Mc;
        }
    }
}
__device__ __forceinline__ void p3b(const Args& a, int gw, int NGW, int lane_in) {
    int lane = lane_in; asm volatile("" : "+v"(lane));
    unsigned char* ws = a.ws;
    bf16* QB = (bf16*)(ws + WS_QB); bf16* KV = (bf16*)(ws + WS_KV);
    const float* rc = (const float*)(ws + WS_ROPEC); const float* rs = (const float*)(ws + WS_ROPES);
    const float* qn = a.in[8]; const float* kn = a.in[9];
    const int j = lane & 31; const float C2 = 0.125f * LOG2E;
    const float qw0 = qn[2 * j], qw1 = qn[2 * j + 1], kw0 = kn[2 * j], kw1 = kn[2 * j + 1];
    for (int m0 = gw * 2; m0 < T; m0 += NGW * 2) {
        unsigned w[2][5]; float cs[2], sn[2];
#pragma unroll
        for (int r = 0; r < 2; ++r) { const int m = m0 + r; const int pos = m & (SEQ - 1); cs[r] = rc[pos * 32 + j]; sn[r] = rs[pos * 32 + j];
#pragma unroll
            for (int i = 0; i < 5; ++i) { const int hh = 2 * i + (lane >> 5);
                const unsigned* p = (hh < 8) ? (const unsigned*)(QB + (size_t)m * 512 + hh * 64 + 2 * j) : (const unsigned*)(KV + (size_t)m * 256 + (hh - 8) * 64 + 2 * j);
                w[r][i] = *p; } }
        asm volatile("" ::: "memory");
#pragma unroll
        for (int r = 0; r < 2; ++r) { const int m = m0 + r;
#pragma unroll
            for (int i = 0; i < 5; ++i) { const int hh = 2 * i + (lane >> 5);
                unsigned* p = (hh < 8) ? (unsigned*)(QB + (size_t)m * 512 + hh * 64 + 2 * j) : (unsigned*)(KV + (size_t)m * 256 + (hh - 8) * 64 + 2 * j);
                const float n0 = (hh < 8) ? qw0 : kw0, n1 = (hh < 8) ? qw1 : kw1, scl = (hh < 8) ? C2 : 1.0f;
                const float x0 = bflo(w[r][i]), x1 = bfhi(w[r][i]);
                float ss = x0 * x0 + x1 * x1;
#pragma unroll
                for (int o = 1; o < 32; o <<= 1) ss += __shfl_xor(ss, o);
                const float rinv = rsqrtf(ss * (1.0f / 64.0f) + EPS);
                const float y0 = x0 * rinv * n0, y1 = x1 * rinv * n1;
                *p = pk2((y0 * cs[r] - y1 * sn[r]) * scl, (y0 * sn[r] + y1 * cs[r]) * scl); } }
    }
}

__device__ __forceinline__ int sigma32(int r) { return (r & 19) | ((r & 4) << 1) | ((r & 8) >> 1); }
__device__ __forceinline__ unsigned cvtpk(float lo, float hi) { unsigned r; asm volatile("v_cvt_pk_bf16_f32 %0, %1, %2" : "=v"(r) : "v"(lo), "v"(hi)); return r; }
#define MFMA_GUARD1(X) asm volatile("s_nop 15\n\ts_nop 7" : "+v"(X))
#define MFMA32(A, B, Cc) __builtin_amdgcn_mfma_f32_32x32x16_bf16(A, B, Cc, 0, 0, 0)
#define CBAR() asm volatile("" ::: "memory")
template <int DIR, bool DIAG> __device__ __forceinline__ void mask_tile(const f32x16& Sin, int tl, int hh, bf16x8& P0, bf16x8& P1) {
    f32x16 S = Sin; MFMA_GUARD1(S);
    unsigned pw[8];
#pragma unroll
    for (int g = 0; g < 16; g += 2) {
        float p0 = S[g], p1 = S[g + 1];
        if (DIAG) { const int s0 = (g & 7) + 8 * hh + 16 * (g >> 3);
            const bool v0 = DIR ? (s0 >= tl) : (s0 <= tl), v1 = DIR ? (s0 + 1 >= tl) : (s0 + 1 <= tl);
            p0 = v0 ? p0 : 0.f; p1 = v1 ? p1 : 0.f; }
        pw[g >> 1] = cvtpk(p0, p1);
    }
    P0 = __builtin_bit_cast(bf16x8, (v4u){pw[0], pw[1], pw[2], pw[3]}); P1 = __builtin_bit_cast(bf16x8, (v4u){pw[4], pw[5], pw[6], pw[7]});
}
#define CFRAG(ks) ({ const int dt_ = (ks) >> 1, s2_ = (ks) & 1; v4u w_; \
        w_.x = cvtpk(C[dt_][8 * s2_ + 0], C[dt_][8 * s2_ + 1]); w_.y = cvtpk(C[dt_][8 * s2_ + 2], C[dt_][8 * s2_ + 3]); \
        w_.z = cvtpk(C[dt_][8 * s2_ + 4], C[dt_][8 * s2_ + 5]); w_.w = cvtpk(C[dt_][8 * s2_ + 6], C[dt_][8 * s2_ + 7]); __builtin_bit_cast(bf16x8, w_); })
#define STORE_NUM(PV, QC, FC, WI, TT) do { const size_t row_ = (size_t)b * SEQ + t0 + 32 * (TT) + tl; \
        if (slice < 4) { bf16* op_ = NUM + row_ * 512; _Pragma("unroll") for (int q4 = 0; q4 < 4; ++q4) { v2u w_; \
            w_.x = cvtpk(FC * PV[4 * q4 + 0] + WI * QC[4 * q4 + 0], FC * PV[4 * q4 + 1] + WI * QC[4 * q4 + 1]); w_.y = cvtpk(FC * PV[4 * q4 + 2] + WI * QC[4 * q4 + 2], FC * PV[4 * q4 + 3] + WI * QC[4 * q4 + 3]); *(v2u*)(op_ + 8 * q4) = w_; } } \
        else if (hh == 0) DEN[row_ * 4] = FC * PV[0] + WI * QC[0]; } while (0)
__device__ __forceinline__ void ml_glds16(const void* gsrc, unsigned lds_dst) { unsigned keep;
    asm volatile("s_mov_b32 %0, m0\n\ts_mov_b32 m0, %2\n\ts_nop 0\n\tglobal_load_lds_dwordx4 %1, off\n\ts_mov_b32 m0, %0" : "=&s"(keep) : "v"(gsrc), "s"(lds_dst) : "memory"); }
template <int DIR> __device__ __forceinline__ void mlstm_block_d(const Args& a, int item, LAS unsigned char* L, int wave, int lane_in) {
    int lane = lane_in; asm volatile("" : "+v"(lane));
    unsigned char* ws = a.ws;
    const int h = (item >> 1) & 3, b = item >> 3;
    const int tl = lane & 31, hh = lane >> 5, slice = wave;
    const unsigned loff = (unsigned)lane * 16u;
    const char* base4 = (wave < 4) ? (const char*)(ws + WS_MQK) + (size_t)(wave >> 1) * ((size_t)T * 1024) : (const char*)a.out + (size_t)((wave - 4) >> 1) * ((size_t)T * 1024);
    const char* srcb = base4 + (size_t)(b * 4 + h) * 524288 + (wave & 1) * 8192 + loff;
    const char* scfp = (const char*)(ws + WS_SCF) + (size_t)item * 32 * 1024 + loff;
    const unsigned lds0 = (unsigned)(uintptr_t)L;
    bf16* NUM = (bf16*)(ws + WS_NUM) + (size_t)DIR * T * 512 + h * 128 + 32 * (slice & 3) + 4 * hh;
    float* DEN = (float*)(ws + WS_DEN) + (size_t)DIR * T * 4 + h;
    constexpr int tA = DIR ? 1 : 0, tB = 1 - tA;
#define ML_ISSUE(TC, BUFO) do { _Pragma("unroll") for (int i_ = 0; i_ < 8; ++i_) ml_glds16(srcb + (size_t)(TC) * 16384 + i_ * 1024, (unsigned)__builtin_amdgcn_readfirstlane(lds0 + (BUFO) + wave * 8192 + i_ * 1024)); \
        if (wave == 7) ml_glds16(scfp + (size_t)(TC) * 1024, (unsigned)__builtin_amdgcn_readfirstlane(lds0 + (BUFO) + 65536)); } while (0)
#define ML_WAITBAR() asm volatile("s_waitcnt vmcnt(0) lgkmcnt(0)\n\ts_barrier" ::: "memory")
    f32x16 C[4];
#pragma unroll
    for (int i = 0; i < 4; ++i) C[i] = (f32x16){};
    if (wave == 5) gate_scan_item(a, item, lane);
    ML_WAITBAR();
    ML_ISSUE(DIR ? 31 : 0, 0);
    ML_WAITBAR();
#pragma nounroll
    for (int c = 0; c < 32; ++c) {
        const int tc = DIR ? 31 - c : c, t0 = tc * 64;
        const int bufo = (c & 1) * ML_BUF;
        if (c + 1 < 32) ML_ISSUE(DIR ? 30 - c : c + 1, ML_BUF - bufo);
        const LAS unsigned char* Lb = L + bufo;
        LAS unsigned char* Lp = L + 2 * ML_BUF;
        bf16x8 vtw[4]; f32x16 qcA = (f32x16){}, qcB = (f32x16){};
        float fcA = 0.f, wiA = 0.f, fcB = 0.f, wiB = 0.f, wold = 0.f;
        LAS float* Ld = (LAS float*)(Lp + 6144);
        if (wave >= 4) {
            if (wave >= 5) {
                const int which = wave - 5, kt_ = (which == 2) ? tB : tA, qt_ = (which == 0) ? tA : tB;
                f32x16 S = (f32x16){};
#pragma unroll
                for (int ks = 0; ks < 8; ++ks) { const bf16x8 kf = *(const LAS bf16x8*)(Lb + 16384 + (kt_ * 8 + ks) * 1024 + loff), qf = *(const LAS bf16x8*)(Lb + (qt_ * 8 + ks) * 1024 + loff); S = MFMA32(kf, qf, S); }
                bf16x8 P0, P1;
                if (which == 1) mask_tile<DIR, false>(S, tl, hh, P0, P1); else mask_tile<DIR, true>(S, tl, hh, P0, P1);
                *(LAS bf16x8*)(Lp + (which * 2 + 0) * 1024 + loff) = P0; *(LAS bf16x8*)(Lp + (which * 2 + 1) * 1024 + loff) = P1;
            }
            const LAS float* Ls = (const LAS float*)(Lb + 65536);
            const int dtd = wave - 4;
#pragma unroll
            for (int k = 0; k < 4; ++k) { const f32x4 w0 = *(const LAS f32x4*)(Ls + 128 + 16 * k + 8 * hh), w1 = *(const LAS f32x4*)(Ls + 128 + 16 * k + 8 * hh + 4); v4u o;
                o.x = cvtpk(w0[0], w0[1]); o.y = cvtpk(w0[2], w0[3]); o.z = cvtpk(w1[0], w1[1]); o.w = cvtpk(w1[2], w1[3]); vtw[k] = __builtin_bit_cast(bf16x8, o); }
            fcA = Ls[32 * tA + tl]; wiA = Ls[64 + 32 * tA + tl]; fcB = Ls[32 * tB + tl]; wiB = Ls[64 + 32 * tB + tl]; wold = Ls[192];
            asm volatile("s_nop 15\n\ts_nop 7" : "+v"(C[0]));
#pragma unroll
            for (int s2 = 0; s2 < 2; ++s2) { v4u w_;
                w_.x = cvtpk(C[0][8 * s2 + 0], C[0][8 * s2 + 1]); w_.y = cvtpk(C[0][8 * s2 + 2], C[0][8 * s2 + 3]); w_.z = cvtpk(C[0][8 * s2 + 4], C[0][8 * s2 + 5]); w_.w = cvtpk(C[0][8 * s2 + 6], C[0][8 * s2 + 7]);
                const bf16x8 cfr = __builtin_bit_cast(bf16x8, w_);
                const bf16x8 qfa = *(const LAS bf16x8*)(Lb + (tA * 8 + 2 * dtd + s2) * 1024 + loff), qfb = *(const LAS bf16x8*)(Lb + (tB * 8 + 2 * dtd + s2) * 1024 + loff);
                qcA = MFMA32(cfr, qfa, qcA); qcB = MFMA32(cfr, qfb, qcB); }
            if (hh == 0) { Ld[dtd * 64 + tl] = qcA[0]; Ld[dtd * 64 + 32 + tl] = qcB[0]; }
        } else {
            const LAS float* Ls = (const LAS float*)(Lb + 65536);
            {   bf16x8 vt[4]; f32x4 wsv[4][2];
#pragma unroll
                for (int k = 0; k < 4; ++k) {
                    vt[k] = *(const LAS bf16x8*)(Lb + 49152 + (slice * 4 + k) * 1024 + loff);
                    wsv[k][0] = *(const LAS f32x4*)(Ls + 128 + 16 * k + 8 * hh); wsv[k][1] = *(const LAS f32x4*)(Ls + 128 + 16 * k + 8 * hh + 4);
                }
#pragma unroll
                for (int k = 0; k < 4; ++k) { const v4u vv = __builtin_bit_cast(v4u, vt[k]); const f32x4 w0 = wsv[k][0], w1 = wsv[k][1]; v4u o;
                    o.x = cvtpk(bflo(vv.x) * w0[0], bfhi(vv.x) * w0[1]); o.y = cvtpk(bflo(vv.y) * w0[2], bfhi(vv.y) * w0[3]);
                    o.z = cvtpk(bflo(vv.z) * w1[0], bfhi(vv.z) * w1[1]); o.w = cvtpk(bflo(vv.w) * w1[2], bfhi(vv.w) * w1[3]); vtw[k] = __builtin_bit_cast(bf16x8, o); }
            }
            fcA = Ls[32 * tA + tl]; wiA = Ls[64 + 32 * tA + tl]; fcB = Ls[32 * tB + tl]; wiB = Ls[64 + 32 * tB + tl]; wold = Ls[192];
            asm volatile("s_nop 15\n\ts_nop 7" : "+v"(C[0]), "+v"(C[1]), "+v"(C[2]), "+v"(C[3]));
#pragma unroll
            for (int ks = 0; ks < 8; ++ks) { const bf16x8 qf = *(const LAS bf16x8*)(Lb + (tA * 8 + ks) * 1024 + loff); qcA = MFMA32(CFRAG(ks), qf, qcA); if ((ks & 3) == 3) CBAR(); }
#pragma unroll
            for (int ks = 0; ks < 8; ++ks) { const bf16x8 qf = *(const LAS bf16x8*)(Lb + (tB * 8 + ks) * 1024 + loff); qcB = MFMA32(CFRAG(ks), qf, qcB); if ((ks & 3) == 3) CBAR(); }
        }
        asm volatile("s_waitcnt lgkmcnt(0)\n\ts_barrier" ::: "memory");
        if (wave < 4) {
            bf16x8 P[6];
#pragma unroll
            for (int i = 0; i < 6; ++i) P[i] = *(const LAS bf16x8*)(Lp + i * 1024 + loff);
            {   f32x16 pv = (f32x16){}; pv = MFMA32(vtw[2 * tA + 0], P[0], pv); pv = MFMA32(vtw[2 * tA + 1], P[1], pv);
                STORE_NUM(pv, qcA, fcA, wiA, tA); }
            {   f32x16 pv = (f32x16){}; pv = MFMA32(vtw[2 * tA + 0], P[2], pv); pv = MFMA32(vtw[2 * tA + 1], P[3], pv); pv = MFMA32(vtw[2 * tB + 0], P[4], pv); pv = MFMA32(vtw[2 * tB + 1], P[5], pv);
                STORE_NUM(pv, qcB, fcB, wiB, tB); }
#pragma unroll
            for (int dt = 0; dt < 4; ++dt) C[dt] = C[dt] * wold;
#pragma unroll
            for (int k = 0; k < 4; ++k)
#pragma unroll
                for (int dt = 0; dt < 4; ++dt) { const bf16x8 kt = *(const LAS bf16x8*)(Lb + 32768 + (dt * 4 + k) * 1024 + loff); C[dt] = MFMA32(kt, vtw[k], C[dt]); }
        } else {
            const int dtd = wave - 4;
            if (wave == 4) {
                bf16x8 P[6];
#pragma unroll
                for (int i = 0; i < 6; ++i) P[i] = *(const LAS bf16x8*)(Lp + i * 1024 + loff);
                f32x16 pa = (f32x16){}, pb = (f32x16){};
                pa = MFMA32(vtw[2 * tA + 0], P[0], pa); pa = MFMA32(vtw[2 * tA + 1], P[1], pa);
                pb = MFMA32(vtw[2 * tA + 0], P[2], pb); pb = MFMA32(vtw[2 * tA + 1], P[3], pb); pb = MFMA32(vtw[2 * tB + 0], P[4], pb); pb = MFMA32(vtw[2 * tB + 1], P[5], pb);
                const float qna = (Ld[tl] + Ld[64 + tl]) + (Ld[128 + tl] + Ld[192 + tl]), qnb = (Ld[32 + tl] + Ld[96 + tl]) + (Ld[160 + tl] + Ld[224 + tl]);
                if (hh == 0) { DEN[((size_t)b * SEQ + t0 + 32 * tA + tl) * 4] = fcA * pa[0] + wiA * qna; DEN[((size_t)b * SEQ + t0 + 32 * tB + tl) * 4] = fcB * pb[0] + wiB * qnb; }
            }
            C[0] = C[0] * wold;
#pragma unroll
            for (int k = 0; k < 4; ++k) { const bf16x8 kt = *(const LAS bf16x8*)(Lb + 32768 + (dtd * 4 + k) * 1024 + loff); C[0] = MFMA32(kt, vtw[k], C[0]); }
        }
        ML_WAITBAR();
    }
}
__device__ __forceinline__ void mlstm_block(const Args& a, int item, LAS unsigned char* L, int wave, int lane) {
    if (item & 1) mlstm_block_d<1>(a, item, L, wave, lane); else mlstm_block_d<0>(a, item, L, wave, lane);
}

__device__ __forceinline__ void finalize_mem(const Args& a, int gw, int NGW, int lane_in) {
    int lane = lane_in; asm volatile("" : "+v"(lane));
    unsigned char* ws = a.ws;
    const bf16* NUM = (const bf16*)(ws + WS_NUM); const float* DEN = (const float*)(ws + WS_DEN); const float* SC = (const float*)(ws + WS_SC);
    const bf16* OPRE = (const bf16*)(ws + WS_OPRE); bf16* MEM = (bf16*)((unsigned char*)a.out + OUT_AM) + (size_t)T * 512; const float* hn = a.in[11];
    const int hd = lane >> 4;
    const f32x4 w0 = *(const f32x4*)(hn + lane * 8), w1 = *(const f32x4*)(hn + lane * 8 + 4);
    for (int m0 = gw * 2; m0 < T; m0 += NGW * 2) {
        v4u nf[2], nb[2], ov[2]; float df[2], db[2], clf[2], clb[2];
#pragma unroll
        for (int q = 0; q < 2; ++q) { const int m = m0 + q; const int b = m >> 11, t = m & (SEQ - 1);
            nf[q] = *(const v4u*)(NUM + (size_t)m * 512 + lane * 8); nb[q] = *(const v4u*)(NUM + (size_t)T * 512 + (size_t)m * 512 + lane * 8);
            df[q] = DEN[(size_t)m * 4 + hd]; db[q] = DEN[(size_t)T * 4 + (size_t)m * 4 + hd];
            clf[q] = SC[(size_t)((b * 4 + hd) * 2 + 0) * 5 * SEQ + 3 * SEQ + t]; clb[q] = SC[(size_t)((b * 4 + hd) * 2 + 1) * 5 * SEQ + 3 * SEQ + t];
            ov[q] = *(const v4u*)(OPRE + (size_t)m * 512 + lane * 8); }
#pragma unroll
        for (int q = 0; q < 2; ++q) { const int m = m0 + q;
            const float rf = 1.0f / fmaxf(fabsf(df[q]), clf[q]), rb = 1.0f / fmaxf(fabsf(db[q]), clb[q]);
            float hv[8];
            hv[0] = bflo(nf[q].x) * rf + bflo(nb[q].x) * rb; hv[1] = bfhi(nf[q].x) * rf + bfhi(nb[q].x) * rb; hv[2] = bflo(nf[q].y) * rf + bflo(nb[q].y) * rb; hv[3] = bfhi(nf[q].y) * rf + bfhi(nb[q].y) * rb;
            hv[4] = bflo(nf[q].z) * rf + bflo(nb[q].z) * rb; hv[5] = bfhi(nf[q].z) * rf + bfhi(nb[q].z) * rb; hv[6] = bflo(nf[q].w) * rf + bflo(nb[q].w) * rb; hv[7] = bfhi(nf[q].w) * rf + bfhi(nb[q].w) * rb;
            float ss = 0.f;
#pragma unroll
            for (int i = 0; i < 8; ++i) ss += hv[i] * hv[i];
#pragma unroll
            for (int o = 1; o < 16; o <<= 1) ss += __shfl_xor(ss, o);
            const float rinv = rsqrtf(ss * (1.0f / 128.0f) + EPS);
            v4u o; o.x = pk2(hv[0] * rinv * w0[0] * bflo(ov[q].x), hv[1] * rinv * w0[1] * bfhi(ov[q].x)); o.y = pk2(hv[2] * rinv * w0[2] * bflo(ov[q].y), hv[3] * rinv * w0[3] * bfhi(ov[q].y));
            o.z = pk2(hv[4] * rinv * w1[0] * bflo(ov[q].z), hv[5] * rinv * w1[1] * bfhi(ov[q].z)); o.w = pk2(hv[6] * rinv * w1[2] * bflo(ov[q].w), hv[7] * rinv * w1[3] * bfhi(ov[q].w));
            *(v4u*)(MEM + (size_t)m * 512 + lane * 8) = o; }
    }
}
__device__ __forceinline__ void final_norm(const Args& a, int gw, int NGW, int lane_in) {
    int lane = lane_in; asm volatile("" : "+v"(lane));
    const float* SS3 = (const float*)(a.ws + WS_SS3); const float* fnw = a.in[19]; const bf16* XB = (const bf16*)(a.ws + WS_XB);
    f32x4 w[4];
    w[0] = *(const f32x4*)(fnw + 8 * lane); w[1] = *(const f32x4*)(fnw + 8 * lane + 4); w[2] = *(const f32x4*)(fnw + 512 + 8 * lane); w[3] = *(const f32x4*)(fnw + 512 + 8 * lane + 4);
    for (int m0 = gw * 4; m0 < T; m0 += NGW * 4) {
        v4u v[4][2]; float r[4];
#pragma unroll
        for (int q = 0; q < 4; ++q) { r[q] = SS3[m0 + q]; const bf16* p = XB + (size_t)(m0 + q) * DM + 8 * lane; v[q][0] = *(const v4u*)p; v[q][1] = *(const v4u*)(p + 512); }
#pragma unroll
        for (int q = 0; q < 4; ++q) { const float rr = rsqrtf(r[q] * (1.0f / 1024.0f) + EPS); float* o = a.out + (size_t)(m0 + q) * DM + 8 * lane;
#pragma unroll
            for (int hlf = 0; hlf < 2; ++hlf) { const v4u x = v[q][hlf];
                const f32x4 y0 = (f32x4){bflo(x.x), bfhi(x.x), bflo(x.y), bfhi(x.y)} * rr * w[2 * hlf], y1 = (f32x4){bflo(x.z), bfhi(x.z), bflo(x.w), bfhi(x.w)} * rr * w[2 * hlf + 1];
                *(f32x4*)(o + 512 * hlf) = y0; *(f32x4*)(o + 512 * hlf + 4) = y1; } }
    }
}

#define XB_TMO      128
#define XB_XCNT(j)  (256  + 64 * (j))
#define XB_XSUB(j)  (1280 + 64 * (j))
#define XB_XGEN(j)  (2304 + 64 * (j))
#define XB_TOP      3328
#define XB_TOPGEN   3392
#define XCD_BAR_WORDS 3456
#define XB_SPIN_CAP (1u << 18)

__device__ __forceinline__ unsigned xb_ld(unsigned* p)              { return __hip_atomic_load(p, __ATOMIC_RELAXED, __HIP_MEMORY_SCOPE_AGENT); }
__device__ __forceinline__ unsigned xb_add(unsigned* p, unsigned v) { return __hip_atomic_fetch_add(p, v, __ATOMIC_RELAXED, __HIP_MEMORY_SCOPE_AGENT); }
__device__ __forceinline__ unsigned xb_xcc_id() { return (unsigned)__builtin_amdgcn_s_getreg((3 << 11) | 20) & 0xFu; }
#define XB_SPIN(cond, bar) do { unsigned _sp = 0; while (cond) { __builtin_amdgcn_s_sleep(1); \
    if ((++_sp & 255u) == 0u) { if (xb_ld(&(bar)[XB_TMO])) break; if (_sp > XB_SPIN_CAP) { atomicAdd(&(bar)[XB_TMO], 1u); break; } } } } while (0)

struct XcdBarrier {
    unsigned* bar; unsigned x;
    volatile LAS unsigned* st;
};

__device__ __forceinline__ XcdBarrier xcd_barrier_post(unsigned* bar, volatile LAS unsigned* st) {
    XcdBarrier b; b.bar = bar; b.x = xb_xcc_id(); b.st = st;
    if (threadIdx.x == 0) (void)xb_add(&bar[XB_XCNT(b.x)], 1u);
    return b;
}
__device__ __forceinline__ void xcd_barrier_complete(unsigned* bar, unsigned x, unsigned& nloc, unsigned& nx) {
    const unsigned G = gridDim.x * gridDim.y * gridDim.z;
    unsigned sum, cnt, mine, sp = 0u;
    for (;;) {
        sum = 0u; cnt = 0u; mine = 0u;
#pragma unroll
        for (unsigned j = 0; j < 16; ++j) { const unsigned c = xb_ld(&bar[XB_XCNT(j)]); sum += c; cnt += (c > 0u) ? 1u : 0u; mine = (j == x) ? c : mine; }
        if (sum == G) break;
        __builtin_amdgcn_s_sleep(1);
        if ((++sp & 255u) == 0u) { if (xb_ld(&bar[XB_TMO])) break; if (sp > XB_SPIN_CAP) { atomicAdd(&bar[XB_TMO], 1u); break; } }
    }
    nloc = mine > 0u ? mine : 1u; nx = cnt > 0u ? cnt : 1u;
}

__device__ __forceinline__ void xcd_barrier(const XcdBarrier& b) {
    asm volatile("s_waitcnt vmcnt(0)" ::: "memory");
    __syncthreads();
    if (threadIdx.x == 0) {
        unsigned* bar = b.bar;
        __builtin_amdgcn_s_waitcnt(0);
        unsigned nloc = b.st[0], nx = b.st[1];
        if (nloc == 0u) { xcd_barrier_complete(bar, b.x, nloc, nx); b.st[0] = nloc; b.st[1] = nx; }
        const unsigned old = xb_add(&bar[XB_XSUB(b.x)], 1u);
        const unsigned gen = old / nloc;
        if (old + 1u == (gen + 1u) * nloc) {
            __builtin_amdgcn_fence(__ATOMIC_RELEASE, "agent");
            asm volatile("s_waitcnt vmcnt(0)" ::: "memory");
            const unsigned og = xb_add(&bar[XB_TOP], 1u);
            const unsigned tg = og / nx;
            if (og + 1u == (tg + 1u) * nx) xb_add(&bar[XB_TOPGEN], 1u);
            else XB_SPIN(xb_ld(&bar[XB_TOPGEN]) == tg, bar);
            __builtin_amdgcn_fence(__ATOMIC_ACQUIRE, "agent");
            xb_add(&bar[XB_XGEN(b.x)], 1u);
            asm volatile("s_waitcnt vmcnt(0)" ::: "memory");
        } else {
            XB_SPIN(xb_ld(&bar[XB_XGEN(b.x)]) == gen, bar);
            __builtin_amdgcn_fence(__ATOMIC_ACQUIRE, "agent");
            asm volatile("s_waitcnt vmcnt(0)" ::: "memory");
        }
    }
    __syncthreads();
}

__global__ void __launch_bounds__(NWAVES * 64, 2) mega_fwd(Args args) {
    extern __shared__ __attribute__((aligned(16))) unsigned char lds[];
    cg::grid_group grid = cg::this_grid();
    LAS unsigned char* L = (LAS unsigned char*)lds;
    volatile LAS unsigned* MISC = (volatile LAS unsigned*)(L + MISC_OFF);
    const int tid = threadIdx.x, lane = tid & 63, wave = __builtin_amdgcn_readfirstlane(tid >> 6);
    const int G = gridDim.x; const int bx = blockIdx.x;
    const int vcu = (G % 8 == 0) ? (bx % 8) * (G / 8) + bx / 8 : bx;
    const int gw = vcu * NWAVES + wave, NGW = G * NWAVES;
    unsigned char* ws = args.ws;
    for (int u = tid; u < 64; u += NWAVES * 64) ((LAS unsigned*)(L + MISC_OFF))[u] = 0u;
    __syncthreads();
    const XcdBarrier xbar = xcd_barrier_post((unsigned*)(ws + WS_CTL) + CW_BAR, MISC + 8);
    if (args.ws == nullptr) grid.sync();
#define GSYNC() xcd_barrier(xbar)
    bf16* XB = (bf16*)(ws + WS_XB); bf16* Hb = (bf16*)(ws + WS_H); bf16* WIN = (bf16*)(ws + WS_WIN);

#define EPI_INIT(E) do { E.ssin = nullptr; E.ssout = nullptr; E.x0 = args.in[0]; E.x1 = args.in[1]; E.f32buf = args.out; E.b0 = nullptr; E.q = (bf16*)(ws + WS_QB); E.kv = (bf16*)(ws + WS_KV); \
    E.mqk = (bf16*)(ws + WS_MQK); E.opre = (bf16*)(ws + WS_OPRE); E.g16 = (float*)(ws + WS_G16); E.gate = nullptr; E.qnw = args.in[8]; E.knw = args.in[9]; E.ropec = (const float*)(ws + WS_ROPEC); E.ropes = (const float*)(ws + WS_ROPES); } while (0)
#define RUN_GEMM(EPI_T, E, Aptr, Bptr, Mv, Nv, Kv) do { pg8::Gemm g; g.A = (Aptr); g.Bt = (Bptr); g.M = (Mv); g.N = (Nv); g.K = (Kv); pg8::StaticOrder S; S.init(g.M, g.N, G, bx); \
    pg8::gemm_phase<EPI_T, pg8::StaticOrder, true, true>(L, g, S, E); } while (0)
    p0_prologue(args, L, gw, NGW, wave, lane);
    GSYNC();
    { typedef pg8::EpiG<pg8::M_SWIGLU> EP; EP E; EPI_INIT(E); E.ssin = (float*)(ws + WS_SS0); E.b0 = Hb; RUN_GEMM(EP, E, XB, (bf16*)(ws + WS_W1GU), T, 2 * DFF, DM); }
    GSYNC();
    { typedef pg8::EpiG<pg8::M_RES, 1, 0, 1> EP; EP E; EPI_INIT(E); E.b0 = XB; E.ssout = (float*)(ws + WS_SS1);     RUN_GEMM(EP, E, Hb, (bf16*)(ws + WS_W1D), T, DM, DFF); }
    GSYNC();
    { typedef pg8::EpiG<pg8::M_WINA> EP; EP E; EPI_INIT(E); E.ssin = (float*)(ws + WS_SS1); RUN_GEMM(EP, E, XB, WIN, T, 2560, DM); }
    { typedef pg8::EpiG<pg8::M_KVT> EP; EP E; EPI_INIT(E); E.ssin = (float*)(ws + WS_SS1); E.b0 = (bf16*)args.out; RUN_GEMM(EP, E, WIN + (size_t)2048 * DM, XB, 1024, T, DM); }
    GSYNC();
    {
        unsigned* qctr = (unsigned*)(ws + WS_CTL);
        for (;;) {
            if (tid == 0) MISC[0] = __hip_atomic_fetch_add(qctr, 1u, __ATOMIC_RELAXED, __HIP_MEMORY_SCOPE_AGENT);
            __syncthreads();
            const int u = __builtin_amdgcn_readfirstlane((int)MISC[0]);
            __syncthreads();
            if (u >= N_MLSTM_BLK + N_ATT_UNITS) break;
            if (u < N_MLSTM_BLK) { mlstm_block(args, u, L, wave, lane); }
            else { const int au = u - N_MLSTM_BLK; const int qb = au & 7, gq = (au >> 3) & 3, kvh = (au >> 5) & 1, b = au >> 6;
                attn_body::attn_unit<8>(b, kvh * 4 + gq, qb, (const attn_body::bf16*)(ws + WS_QB), (const attn_body::bf16*)(ws + WS_KV), (const attn_body::bf16*)(ws + WS_KV) + 128, (attn_body::bf16*)((unsigned char*)args.out + OUT_AM), (char*)lds); }
        }
    }
    GSYNC();
    { typedef pg8::EpiG<pg8::M_GAGM> EP; EP E; EPI_INIT(E); E.ssin = (float*)(ws + WS_SS1); E.b0 = (bf16*)(ws + WS_GA); E.gate = (bf16*)args.out; RUN_GEMM(EP, E, XB, WIN + (size_t)3072 * DM, T, 2048, DM); }
    finalize_mem(args, gw, NGW, lane);
    GSYNC();
    { typedef pg8::EpiG<pg8::M_UPF> EP; EP E; EPI_INIT(E); E.q = (bf16*)(ws + WS_GA); E.gate = (bf16*)args.out; E.b0 = (bf16*)(ws + WS_MERGED); { pg8::Gemm g; g.A = (bf16*)((unsigned char*)args.out + OUT_AM); g.Bt = (bf16*)(ws + WS_WA); g.M = T; g.N = DM; g.K = 512; pg8::HalfOrder S; S.init(T, DM, G, bx);
        pg8::gemm_phase<EP, pg8::HalfOrder, true, true>(L, g, S, E); } }
    GSYNC();
    { typedef pg8::EpiG<pg8::M_RES, 1, 0, 1> EP; EP E; EPI_INIT(E); E.b0 = XB; E.ssout = (float*)(ws + WS_SS2); RUN_GEMM(EP, E, (bf16*)(ws + WS_MERGED), (bf16*)(ws + WS_WOUT), T, DM, DM); }
    GSYNC();
    { typedef pg8::EpiG<pg8::M_SWIGLU> EP; EP E; EPI_INIT(E); E.ssin = (float*)(ws + WS_SS2); E.b0 = Hb; RUN_GEMM(EP, E, XB, (bf16*)(ws + WS_W2GU), T, 2 * DFF, DM); }
    GSYNC();
    { typedef pg8::EpiG<pg8::M_RES, 1, 0, 1> EP; EP E; EPI_INIT(E); E.b0 = XB; E.ssout = (float*)(ws + WS_SS3); RUN_GEMM(EP, E, Hb, (bf16*)(ws + WS_W2D), T, DM, DFF); }
    GSYNC();
    final_norm(args, gw, NGW, lane);
}

extern "C" void kernel_launch(void* const* d_in, const int* in_sizes, int n_in, void* d_out, int out_size, void* d_ws, size_t ws_size, hipStream_t stream) {
    static int grid = 0;
    if (grid == 0) {
        int dev = 0, cus = 0, per_cu = 0;
        if (n_in != 20 || out_size != T * DM || ws_size < WS_END) { fprintf(stderr, "kernel_launch: unexpected shapes n_in %d out %d ws %zu\n", n_in, out_size, ws_size); grid = -1; return; }
        (void)hipGetDevice(&dev);
        (void)hipDeviceGetAttribute(&cus, hipDeviceAttributeMultiprocessorCount, dev);
        (void)hipFuncSetAttribute((const void*)mega_fwd, hipFuncAttributeMaxDynamicSharedMemorySize, LDS_BYTES);
        (void)hipOccupancyMaxActiveBlocksPerMultiprocessor(&per_cu, (const void*)mega_fwd, NWAVES * 64, LDS_BYTES);
        if (per_cu < 1) per_cu = 1;
        if (per_cu > 1) per_cu = 1;
        grid = cus * per_cu;
        fprintf(stderr, "kernel_launch: grid %d ws %zu\n", grid, ws_size);
    }
    if (grid < 0) return;
    (void)hipMemsetAsync((char*)d_ws + WS_CTL, 0, CTL_ZERO_BYTES, stream);
    Args a{};
    for (int i = 0; i < 20; ++i) a.in[i] = (const float*)d_in[i];
    a.out = (float*)d_out; a.ws = (unsigned char*)d_ws;
    void* kargs[] = {&a};
    hipError_t e = hipLaunchCooperativeKernel((void*)mega_fwd, dim3(grid), dim3(NWAVES * 64), kargs, LDS_BYTES, stream);
    if (e != hipSuccess) fprintf(stderr, "kernel_launch: cooperative launch failed: %s (grid %d)\n", hipGetErrorString(e), grid);
}
```

```cpp
#include <hip/hip_runtime.h>
#include <hip/hip_cooperative_groups.h>
#include <cstdio>
#include <cstdint>
namespace pg8 {
#define PG8_LAS __attribute__((address_space(3)))
typedef unsigned short bf16_t;
typedef short bf16x8 __attribute__((ext_vector_type(8)));
typedef float f32x4 __attribute__((ext_vector_type(4)));
typedef unsigned u32x4 __attribute__((ext_vector_type(4)));
constexpr int BM = 256, BK = 64, HALF = 128, HTB = HALF * BK * 2  , STAGE_BYTES = 8 * HTB, NXCD = 8, WGM = 8;

__host__ __device__ __forceinline__ int lds_byte(int r, int c) { const int st = (r >> 4) * 2 + (c >> 5), rr = r & 15, cc = c & 31, ob = rr * 64 + cc * 2; return st * 1024 + (ob ^ (((ob >> 9) & 1) << 5)); }
__host__ __device__ __forceinline__ void stage_rc(int b, int& R, int& C) { const int st = b / 1024, sb = b % 1024, swz = sb ^ (((sb >> 9) & 1) << 5); R = (st >> 1) * 16 + swz / 64; C = (st & 1) * 32 + (swz % 64) / 2; }
__host__ __device__ __forceinline__ int perm32(int rho) { const int n = rho >> 4, i = rho & 15; return 8 * (i >> 2) + 4 * n + (i & 3); }

struct Unit { int pm, pn; };
struct Gemm { const bf16_t* A; const bf16_t* Bt; int M, N, K; };

struct StaticOrder {
    int nM, nN, nwg, G, c;
    __host__ __device__ void init(int M, int N, int G_, int c_) { nM = M / BM; nN = N / BM; nwg = nM * nN; G = G_; c = c_; }
    __host__ __device__ bool next(int i, Unit& u) const {
        const long L = (long)i * G + c; if (L >= nwg) return false;
        int wgid = (int)L; { const int q = nwg / NXCD, r = nwg % NXCD, xcd = wgid % NXCD, off = wgid / NXCD; wgid = (xcd < r ? xcd * (q + 1) : r * (q + 1) + (xcd - r) * q) + off; }
        const int nig = WGM * nN, gid = wgid / nig, fm = gid * WGM, gsz = (nM - fm) < WGM ? (nM - fm) : WGM;
        u.pm = fm + ((wgid % nig) % gsz); u.pn = (wgid % nig) / gsz; return true;
    }
    __device__ __forceinline__ void a_ready(const Unit&) const {}
    __device__ __forceinline__ void done(const Unit&) const {}
};

struct HalfOrder {
    StaticOrder so;
    __host__ __device__ void init(int M, int N, int G_, int c_) { so.init(M, N, G_, c_); }
    __host__ __device__ bool next(int i, Unit& u) const { if (!so.next(i >> 1, u)) return false; if (i & 1) { u.pm += so.nM; u.pn += so.nN; } return true; }
    __device__ __forceinline__ void a_ready(const Unit&) const {}
    __device__ __forceinline__ void done(const Unit&) const {}
};
__device__ __forceinline__ unsigned cvt_pk_bf16(float lo, float hi) { unsigned r; asm volatile("v_cvt_pk_bf16_f32 %0, %1, %2" : "=v"(r) : "v"(lo), "v"(hi)); return r; }
typedef float f32x2 __attribute__((ext_vector_type(2)));
enum { M_SWIGLU = 1, M_RES = 2, M_WINA = 3, M_KVT = 4, M_GAGM = 5, M_UPA = 6, M_UPM = 7, M_UPF = 8 };
__device__ __forceinline__ float sigm(float v) { return __builtin_amdgcn_rcpf(1.0f + __builtin_amdgcn_exp2f(-1.4426950408889634f * v)); }
__device__ __forceinline__ u32x4 pack8(f32x4 a, f32x4 b) { u32x4 w; w.x = cvt_pk_bf16(a[0], a[1]); w.y = cvt_pk_bf16(a[2], a[3]); w.z = cvt_pk_bf16(b[0], b[1]); w.w = cvt_pk_bf16(b[2], b[3]); return w; }
__device__ __forceinline__ void unpack8(u32x4 w, f32x4& a, f32x4& b) {
    a[0] = __uint_as_float(w.x << 16); a[1] = __uint_as_float(w.x & 0xffff0000u); a[2] = __uint_as_float(w.y << 16); a[3] = __uint_as_float(w.y & 0xffff0000u);
    b[0] = __uint_as_float(w.z << 16); b[1] = __uint_as_float(w.z & 0xffff0000u); b[2] = __uint_as_float(w.w << 16); b[3] = __uint_as_float(w.w & 0xffff0000u); }
constexpr int TOK = 49152, NPROMPT = 16384;
__device__ __forceinline__ int sigma32e(int r) { return (r & 19) | ((r & 4) << 1) | ((r & 8) >> 1); }
template <int mode, int reskind = 0, int wf32 = 0, int wbf = 0> struct EpiG {
    static constexpr bool PERM = true, AFTER_DRAIN = false, HAS_MID = (mode == M_UPF);
    const float* ssin; float* ssout; const float* x0; const float* x1; float* f32buf;
    bf16_t* b0; bf16_t* q; bf16_t* kv; bf16_t* mqk; bf16_t* opre; float* g16; const bf16_t* gate;
    const float* qnw; const float* knw; const float* ropec; const float* ropes;
    __device__ __forceinline__ bool is_first_half(const Unit& u) const { return u.pm < TOK / BM; }
    __device__ __forceinline__ void mid(f32x4 (&acc)[2][2][4][2], const Unit& u, int wr, int wc, int fr, int fq) const {
        const int rowb = u.pm * BM + wr * 64 + fr; const int cw = wc * 32 + 8 * fq;
#pragma unroll
        for (int ai = 0; ai < 2; ++ai) {
            u32x4 ga[4][2], gm[4][2];
#pragma unroll
            for (int m = 0; m < 4; ++m) { const int row = rowb + ai * HALF + m * 16;
#pragma unroll
                for (int bj = 0; bj < 2; ++bj) { const size_t o = (size_t)row * 1024 + u.pn * BM + bj * HALF + cw; ga[m][bj] = *(const u32x4*)(q + o); gm[m][bj] = *(const u32x4*)(gate + o); } }
            asm volatile("" ::: "memory");
#pragma unroll
            for (int m = 0; m < 4; ++m)
#pragma unroll
                for (int bj = 0; bj < 2; ++bj) { f32x4 a0, a1, m0, m1; unpack8(ga[m][bj], a0, a1); unpack8(gm[m][bj], m0, m1);
#pragma unroll
                    for (int i = 0; i < 4; ++i) { acc[ai][bj][m][0][i] *= a0[i] * __builtin_amdgcn_rcpf(m0[i]); acc[ai][bj][m][1][i] *= a1[i] * __builtin_amdgcn_rcpf(m1[i]); } }
            asm volatile("" ::: "memory"); }
    }
    __device__ __forceinline__ void operator()(const f32x4 (&acc)[2][2][4][2], const Unit& u, int wr, int wc, int fr, int fq) const {
        const int rowb = u.pm * BM + wr * 64 + fr;
        const int cw = wc * 32 + 8 * fq;
        if (mode == M_SWIGLU) {
#pragma unroll
            for (int ai = 0; ai < 2; ++ai)
#pragma unroll
                for (int m = 0; m < 4; ++m) { const int row = rowb + ai * HALF + m * 16; const float r = rsqrtf(ssin[row] * (1.0f / 1024.0f) + 1e-6f);
                    f32x4 g0 = acc[ai][0][m][0] * r, g1 = acc[ai][0][m][1] * r, u0 = acc[ai][1][m][0] * r, u1 = acc[ai][1][m][1] * r;
#pragma unroll
                    for (int i = 0; i < 4; ++i) { g0[i] = g0[i] * sigm(g0[i]) * u0[i]; g1[i] = g1[i] * sigm(g1[i]) * u1[i]; }
                    *(u32x4*)(b0 + (size_t)row * 2816 + u.pn * 128 + cw) = pack8(g0, g1); }
        } else if (mode == M_RES) {
            u32x4 rball[2][4][2];
            if (reskind == 1) {
#pragma unroll
                for (int ai = 0; ai < 2; ++ai)
#pragma unroll
                    for (int m = 0; m < 4; ++m)
#pragma unroll
                        for (int bj = 0; bj < 2; ++bj) rball[ai][m][bj] = *(const u32x4*)(b0 + (size_t)(rowb + ai * HALF + m * 16) * 1024 + u.pn * BM + bj * HALF + cw);
                asm volatile("" ::: "memory"); }
#pragma unroll
            for (int ai = 0; ai < 2; ++ai) {
                f32x4 rf[4][2][2]; u32x4 rb[4][2];
#pragma unroll
                for (int m = 0; m < 4; ++m) { const int row = rowb + ai * HALF + m * 16;
#pragma unroll
                    for (int bj = 0; bj < 2; ++bj) { const int col = u.pn * BM + bj * HALF + cw;
                        if (reskind == 0) { const float* p = (row < NPROMPT ? x0 + (size_t)row * 1024 : x1 + (size_t)(row - NPROMPT) * 1024) + col; rf[m][bj][0] = *(const f32x4*)p; rf[m][bj][1] = *(const f32x4*)(p + 4); }
                        else if (reskind == 1) rb[m][bj] = rball[ai][m][bj];
                        else { const float* p = f32buf + (size_t)row * 1024 + col; rf[m][bj][0] = *(const f32x4*)p; rf[m][bj][1] = *(const f32x4*)(p + 4); } } }
                asm volatile("" ::: "memory");
#pragma unroll
                for (int m = 0; m < 4; ++m) { const int row = rowb + ai * HALF + m * 16; float ssq = 0.f;
#pragma unroll
                    for (int bj = 0; bj < 2; ++bj) { const int col = u.pn * BM + bj * HALF + cw; f32x4 r0, r1;
                        if (reskind == 1) unpack8(rb[m][bj], r0, r1); else { r0 = rf[m][bj][0]; r1 = rf[m][bj][1]; }
                        const f32x4 y0 = r0 + acc[ai][bj][m][0], y1 = r1 + acc[ai][bj][m][1];
                        ssq += (y0[0] * y0[0] + y0[1] * y0[1]) + (y0[2] * y0[2] + y0[3] * y0[3]) + (y1[0] * y1[0] + y1[1] * y1[1]) + (y1[2] * y1[2] + y1[3] * y1[3]);
                        if (wf32) { float* p = f32buf + (size_t)row * 1024 + col; *(f32x4*)p = y0; *(f32x4*)(p + 4) = y1; }
                        if (wbf) *(u32x4*)(b0 + (size_t)row * 1024 + col) = pack8(y0, y1); }
                    ssq += __shfl_xor(ssq, 16); ssq += __shfl_xor(ssq, 32);
                    if (fq == 0) unsafeAtomicAdd(ssout + row, ssq); }
                asm volatile("" ::: "memory"); }
        } else if (mode == M_WINA && u.pn < 3) {
            const int pn = u.pn; const bool isq = pn < 2, nrm = isq || wc < 2;
            const float* nw = isq ? qnw : knw; const float scl = isq ? 0.125f * 1.4426950408889634f : 1.0f;
            f32x4 w00 = (f32x4){1.f, 1.f, 1.f, 1.f}, w01 = w00, w10 = w00, w11 = w00;
            if (nrm) { w00 = *(const f32x4*)(nw + 8 * fq); w01 = *(const f32x4*)(nw + 8 * fq + 4); w10 = *(const f32x4*)(nw + 32 + 8 * fq); w11 = *(const f32x4*)(nw + 32 + 8 * fq + 4); }
#pragma unroll
            for (int ai = 0; ai < 2; ++ai)
#pragma unroll
                for (int m = 0; m < 4; ++m) { const int row = rowb + ai * HALF + m * 16; const float r = rsqrtf(ssin[row] * (1.0f / 1024.0f) + 1e-6f);
                    f32x4 a0 = acc[ai][0][m][0] * r, a1 = acc[ai][0][m][1] * r, b0v = acc[ai][1][m][0] * r, b1v = acc[ai][1][m][1] * r;
                    if (nrm) {
                        float ss = (a0[0] * a0[0] + a0[1] * a0[1]) + (a0[2] * a0[2] + a0[3] * a0[3]) + (a1[0] * a1[0] + a1[1] * a1[1]) + (a1[2] * a1[2] + a1[3] * a1[3])
                                 + (b0v[0] * b0v[0] + b0v[1] * b0v[1]) + (b0v[2] * b0v[2] + b0v[3] * b0v[3]) + (b1v[0] * b1v[0] + b1v[1] * b1v[1]) + (b1v[2] * b1v[2] + b1v[3] * b1v[3]);
                        ss += __shfl_xor(ss, 16); ss += __shfl_xor(ss, 32);
                        const float rinv = rsqrtf(ss * (1.0f / 64.0f) + 1e-6f);
                        const int pos = row & 2047;
                        const f32x4 c0 = *(const f32x4*)(ropec + pos * 32 + 4 * fq), s0 = *(const f32x4*)(ropes + pos * 32 + 4 * fq);
                        const f32x4 c1 = *(const f32x4*)(ropec + pos * 32 + 16 + 4 * fq), s1 = *(const f32x4*)(ropes + pos * 32 + 16 + 4 * fq);
                        a0 = a0 * rinv * w00; a1 = a1 * rinv * w01; b0v = b0v * rinv * w10; b1v = b1v * rinv * w11;
                        const f32x4 ra0 = (f32x4){a0[0] * c0[0] - a0[1] * s0[0], a0[0] * s0[0] + a0[1] * c0[0], a0[2] * c0[1] - a0[3] * s0[1], a0[2] * s0[1] + a0[3] * c0[1]} * scl;
                        const f32x4 ra1 = (f32x4){a1[0] * c0[2] - a1[1] * s0[2], a1[0] * s0[2] + a1[1] * c0[2], a1[2] * c0[3] - a1[3] * s0[3], a1[2] * s0[3] + a1[3] * c0[3]} * scl;
                        const f32x4 rb0 = (f32x4){b0v[0] * c1[0] - b0v[1] * s1[0], b0v[0] * s1[0] + b0v[1] * c1[0], b0v[2] * c1[1] - b0v[3] * s1[1], b0v[2] * s1[1] + b0v[3] * c1[1]} * scl;
                        const f32x4 rb1 = (f32x4){b1v[0] * c1[2] - b1v[1] * s1[2], b1v[0] * s1[2] + b1v[1] * c1[2], b1v[2] * c1[3] - b1v[3] * s1[3], b1v[2] * s1[3] + b1v[3] * c1[3]} * scl;
                        bf16_t* dp = isq ? q + (size_t)row * 512 + (pn * 4 + wc) * 64 + 8 * fq : kv + (size_t)row * 256 + wc * 64 + 8 * fq;
                        *(u32x4*)dp = pack8(ra0, ra1); *(u32x4*)(dp + 32) = pack8(rb0, rb1);
                    } else {
                        bf16_t* dp = kv + (size_t)row * 256 + 128 + (wc - 2) * 32 + 8 * fq;
                        *(u32x4*)dp = pack8(a0, a1); *(u32x4*)(dp + 64) = pack8(b0v, b1v);
                    } }
        } else if (mode == M_WINA) {
            bf16_t* dst; int ld, cofs, kind = 0; const int pn = u.pn;
            if (pn < 2) { dst = q; ld = 512; cofs = pn * 256; }
            else if (pn == 2) { dst = kv; ld = 256; cofs = 0; }
            else if (pn < 5) { dst = mqk; ld = 0; cofs = (pn - 3) * 256; kind = 3; }
            else if (pn == 5) { dst = mqk; ld = 0; cofs = 0; kind = 2; }
            else if (pn < 8) { dst = opre; ld = 512; cofs = (pn - 6) * 256; kind = 1; }
            else { dst = mqk + (size_t)TOK * 512; ld = 1; cofs = (pn - 8) * 256; kind = 3; }
#pragma unroll
            for (int ai = 0; ai < 2; ++ai)
#pragma unroll
                for (int m = 0; m < 4; ++m) { const int row = rowb + ai * HALF + m * 16; const float r = rsqrtf(ssin[row] * (1.0f / 1024.0f) + 1e-6f);
#pragma unroll
                    for (int bj = 0; bj < 2; ++bj) { f32x4 v0 = acc[ai][bj][m][0] * r, v1 = acc[ai][bj][m][1] * r;
                        if (kind == 2) { if (bj == 0 && wc == 0 && fq < 2) { float* gp = g16 + (size_t)row * 16 + 8 * fq; *(f32x4*)gp = v0; *(f32x4*)(gp + 4) = v1; } }
                        else if (kind == 3) {
                            const int c0 = cofs + bj * HALF + cw, hd = c0 >> 7, d0 = c0 & 127, ks = d0 >> 4, hh = (d0 >> 3) & 1;
                            const int bb = row >> 11, t = row & 2047, chunk = t >> 6, ti = (t >> 5) & 1; int r = t & 31; if (ld) r = sigma32e(r);
                            const size_t off = ((((size_t)((bb * 4 + hd) * 32 + chunk) * 2 + ti) * 8 + ks) * 64 + hh * 32 + r) * 8;
                            *(u32x4*)(dst + off) = pack8(v0, v1); }
                        else { if (kind == 1) {
#pragma unroll
                                for (int i = 0; i < 4; ++i) { v0[i] = sigm(v0[i]); v1[i] = sigm(v1[i]); } }
                            *(u32x4*)(dst + (size_t)row * ld + cofs + bj * HALF + cw) = pack8(v0, v1); } } }
        } else if (mode == M_KVT) {
            f32x4 rc[2][2];
#pragma unroll
            for (int bj = 0; bj < 2; ++bj) { const float* sp = ssin + u.pn * BM + bj * HALF + cw;
#pragma unroll
                for (int n = 0; n < 2; ++n) { const f32x4 s = *(const f32x4*)(sp + 4 * n);
#pragma unroll
                    for (int i = 0; i < 4; ++i) rc[bj][n][i] = rsqrtf(s[i] * (1.0f / 1024.0f) + 1e-6f); } }
#pragma unroll
            for (int ai = 0; ai < 2; ++ai)
#pragma unroll
                for (int m = 0; m < 4; ++m) { const int row = rowb + ai * HALF + m * 16;
#pragma unroll
                    for (int bj = 0; bj < 2; ++bj) {
                        const int isv = row >> 9, nn = row & 511, hd = nn >> 7, d = nn & 127, m0 = u.pn * BM + bj * HALF + cw;
                        const int bb = m0 >> 11, s = m0 & 2047, chunk = s >> 6, k = (s >> 4) & 3, hh = (s >> 3) & 1;
                        const int l64 = hh * 32 + (isv ? (d & 31) : sigma32e(d & 31));
                        const size_t off = (((((size_t)(bb * 4 + hd) * 32 + chunk) * 4 + (d >> 5)) * 4 + k) * 64 + l64) * 8;
                        *(u32x4*)(b0 + (size_t)isv * TOK * 512 + off) = pack8(acc[ai][bj][m][0] * rc[bj][0], acc[ai][bj][m][1] * rc[bj][1]); } }
        } else if (mode == M_GAGM) {
#pragma unroll
            for (int ai = 0; ai < 2; ++ai)
#pragma unroll
                for (int m = 0; m < 4; ++m) { const int row = rowb + ai * HALF + m * 16; const float r = rsqrtf(ssin[row] * (1.0f / 1024.0f) + 1e-6f);
#pragma unroll
                    for (int bj = 0; bj < 2; ++bj) { f32x4 v0 = acc[ai][bj][m][0] * r, v1 = acc[ai][bj][m][1] * r;
#pragma unroll
                        for (int i = 0; i < 4; ++i) { v0[i] = sigm(v0[i]); v1[i] = sigm(v1[i]); }
                        bf16_t* gd = (u.pn < 4) ? b0 + (size_t)row * 1024 + u.pn * BM : (bf16_t*)gate + (size_t)row * 1024 + (u.pn - 4) * BM;
                        *(u32x4*)(gd + bj * HALF + cw) = pack8(v0, v1); } }
        } else if (mode == M_UPF) {
            const int rowb = (u.pm - TOK / BM) * BM + wr * 64 + fr; const int pn0 = u.pn - 4;
#pragma unroll
            for (int ai = 0; ai < 2; ++ai) {
                u32x4 gm[4][2];
#pragma unroll
                for (int m = 0; m < 4; ++m) { const int row = rowb + ai * HALF + m * 16;
#pragma unroll
                    for (int bj = 0; bj < 2; ++bj) gm[m][bj] = *(const u32x4*)(gate + (size_t)row * 1024 + pn0 * BM + bj * HALF + cw); }
                asm volatile("" ::: "memory");
#pragma unroll
                for (int m = 0; m < 4; ++m) { const int row = rowb + ai * HALF + m * 16;
#pragma unroll
                    for (int bj = 0; bj < 2; ++bj) { f32x4 m0, m1; unpack8(gm[m][bj], m0, m1);
                        *(u32x4*)(b0 + (size_t)row * 1024 + pn0 * BM + bj * HALF + cw) = pack8(m0 * acc[ai][bj][m][0], m1 * acc[ai][bj][m][1]); } }
                asm volatile("" ::: "memory"); }
        } else {
#pragma unroll
            for (int ai = 0; ai < 2; ++ai) {
                u32x4 gw[4][2], pw[4][2];
#pragma unroll
                for (int m = 0; m < 4; ++m) { const int row = rowb + ai * HALF + m * 16;
#pragma unroll
                    for (int bj = 0; bj < 2; ++bj) { const int col = u.pn * BM + bj * HALF + cw; gw[m][bj] = *(const u32x4*)(gate + (size_t)row * 2048 + col);
                        if (mode == M_UPM) pw[m][bj] = *(const u32x4*)(b0 + (size_t)row * 1024 + col); } }
                asm volatile("" ::: "memory");
#pragma unroll
                for (int m = 0; m < 4; ++m) { const int row = rowb + ai * HALF + m * 16;
#pragma unroll
                    for (int bj = 0; bj < 2; ++bj) { const int col = u.pn * BM + bj * HALF + cw; f32x4 g0, g1; unpack8(gw[m][bj], g0, g1);
                        f32x4 y0 = g0 * acc[ai][bj][m][0], y1 = g1 * acc[ai][bj][m][1];
                        if (mode == M_UPM) { f32x4 p0, p1; unpack8(pw[m][bj], p0, p1); y0 += p0; y1 += p1; }
                        *(u32x4*)(b0 + (size_t)row * 1024 + col) = pack8(y0, y1); } }
                asm volatile("" ::: "memory"); }
        }
    }
};
template <class Epi, class Sched, bool ALIGN_EPI = false, bool SP2 = false>
__device__ __forceinline__ void gemm_phase(PG8_LAS unsigned char* lds, const Gemm g, const Sched& S, const Epi& E) {
    int tid_l = threadIdx.x; asm volatile("" : "+v"(tid_l)); const int tid = tid_l, wid = __builtin_amdgcn_readfirstlane(tid >> 6), lane = tid & 63, wr = wid >> 2, wc = wid & 3, fr = lane & 15, fq = lane >> 4;
    const int K = g.K, nt = K / BK;
    unsigned voffA[2], voffB[2];
#pragma unroll
    for (int i = 0; i < 2; ++i) { int R, C; stage_rc(tid * 16 + i * 8192, R, C); const int Rb = Epi::PERM ? ((R & ~31) + perm32(R & 31)) : R;
        voffA[i] = (unsigned)(R * K + C) * 2u; voffB[i] = (unsigned)(Rb * K + C) * 2u; }
    const size_t kstep = (size_t)(BK * 2);
    const size_t hstep = (size_t)HALF * K * 2;
    const size_t tstep = 2 * hstep;
    const unsigned ldsw = (unsigned)wid * 1024u;
    const int aoff = lds_byte(wr * 64 + fr, fq * 8), boff = lds_byte(wc * 32 + fr, fq * 8);
#define PG8_SA(b, h) (((b) * 2 + (h)) * HTB)
#define PG8_SB(b, h) ((4 + (b) * 2 + (h)) * HTB)
#define PG8_STAGE(bufoff, gbase, voff) do { _Pragma("unroll") for (int _i = 0; _i < 2; ++_i) \
        __builtin_amdgcn_global_load_lds((const unsigned*)((const char*)(gbase) + (voff)[_i]), (PG8_LAS unsigned*)(lds + (bufoff) + ldsw + _i * 8192), 16, 0, 0); } while (0)
#define PG8_LDA(dst, b, h) do { _Pragma("unroll") for (int m = 0; m < 4; ++m) _Pragma("unroll") for (int k = 0; k < 2; ++k) dst[m][k] = *(const PG8_LAS bf16x8*)(lds + PG8_SA(b, h) + aoff + m * 2048 + k * 1024); } while (0)
#define PG8_LDB(dst, b, h) do { _Pragma("unroll") for (int n = 0; n < 2; ++n) _Pragma("unroll") for (int k = 0; k < 2; ++k) dst[n][k] = *(const PG8_LAS bf16x8*)(lds + PG8_SB(b, h) + boff + n * 2048 + k * 1024); } while (0)
#define PG8_MMA(ai, bj, At, Bt) do { __builtin_amdgcn_s_setprio(1); _Pragma("unroll") for (int m = 0; m < 4; ++m) _Pragma("unroll") for (int n = 0; n < 2; ++n) _Pragma("unroll") for (int k = 0; k < 2; ++k) \
        acc[ai][bj][m][n] = __builtin_amdgcn_mfma_f32_16x16x32_bf16(Bt[n][k], At[m][k], acc[ai][bj][m][n], 0, 0, 0); __builtin_amdgcn_s_setprio(0); } while (0)
#define PG8_WAIT_V(n) asm volatile("s_waitcnt vmcnt(" #n ")" ::: "memory")
#define PG8_WAIT_L(n) asm volatile("s_waitcnt lgkmcnt(" #n ")" ::: "memory")
#define PG8_BAR __builtin_amdgcn_s_barrier()
#define PG8_SCHED __builtin_amdgcn_sched_barrier(0)
    Unit cur, nxt; int ui = 0;
    if (!S.next(0, cur)) return;
    f32x4 acc[2][2][4][2];
#pragma unroll
    for (int a = 0; a < 2; ++a)
#pragma unroll
        for (int b = 0; b < 2; ++b)
#pragma unroll
            for (int m = 0; m < 4; ++m)
#pragma unroll
                for (int n = 0; n < 2; ++n) acc[a][b][m][n] = (f32x4){0.f, 0.f, 0.f, 0.f};
    bf16x8 At[4][2], B0[2][2], B1[2][2];
    const char* cA = (const char*)g.A + (size_t)cur.pm * tstep; const char* cB = (const char*)g.Bt + (size_t)cur.pn * tstep;
    S.a_ready(cur);
    if constexpr (SP2) {
        PG8_STAGE(PG8_SB(0, 0), cB, voffB); PG8_STAGE(PG8_SB(0, 1), cB + hstep, voffB); PG8_STAGE(PG8_SA(0, 0), cA, voffA); PG8_STAGE(PG8_SA(0, 1), cA + hstep, voffA);
        if (wr == 1) PG8_BAR;
        PG8_WAIT_V(2); PG8_BAR;
        PG8_STAGE(PG8_SB(1, 0), cB + kstep, voffB); PG8_STAGE(PG8_SA(1, 0), cA + kstep, voffA); PG8_STAGE(PG8_SB(1, 1), cB + hstep + kstep, voffB);
        PG8_WAIT_V(6); PG8_BAR;
    } else {
        PG8_STAGE(PG8_SB(0, 0), cB, voffB); PG8_STAGE(PG8_SA(0, 0), cA, voffA); PG8_STAGE(PG8_SB(0, 1), cB + hstep, voffB); PG8_STAGE(PG8_SA(0, 1), cA + hstep, voffA);
        if (wr == 1) PG8_BAR;
        PG8_WAIT_V(4); PG8_BAR;
        PG8_STAGE(PG8_SB(1, 0), cB + kstep, voffB); PG8_STAGE(PG8_SA(1, 0), cA + kstep, voffA); PG8_STAGE(PG8_SB(1, 1), cB + hstep + kstep, voffB);
        PG8_WAIT_V(6); PG8_BAR;
    }
    for (;;) {
        const bool has_next = S.next(ui + 1, nxt);
        const char* nA = has_next ? (const char*)g.A + (size_t)nxt.pm * tstep : cA; const char* nB = has_next ? (const char*)g.Bt + (size_t)nxt.pn * tstep : cB;
        for (int t = 0; t < nt; t += 2) {
            const bool last = (t == nt - 2);
            const char* a1 = cA + (size_t)(t + 1) * kstep;
            const char* a2 = last ? nA : cA + (size_t)(t + 2) * kstep; const char* b2 = last ? nB : cB + (size_t)(t + 2) * kstep;
            const char* a3 = a2 + kstep; const char* b3 = b2 + kstep;
            if (last && has_next) S.a_ready(nxt);
            if constexpr (SP2) {
            PG8_LDB(B0, 0, 0); PG8_LDB(B1, 0, 1); PG8_SCHED; PG8_LDA(At, 0, 0); PG8_STAGE(PG8_SA(1, 1), a1 + hstep, voffA);
            PG8_WAIT_V(8); PG8_WAIT_L(0); PG8_BAR; PG8_MMA(0, 0, At, B0); PG8_MMA(0, 1, At, B1); PG8_BAR; PG8_SCHED;
            PG8_LDA(At, 0, 1); PG8_STAGE(PG8_SB(0, 0), b2, voffB); PG8_STAGE(PG8_SB(0, 1), b2 + hstep, voffB); PG8_STAGE(PG8_SA(0, 0), a2, voffA);
            PG8_WAIT_V(8); PG8_WAIT_L(0); PG8_BAR; PG8_MMA(1, 0, At, B0); PG8_MMA(1, 1, At, B1); PG8_BAR; PG8_SCHED;
            PG8_LDB(B0, 1, 0); PG8_LDB(B1, 1, 1); PG8_SCHED; PG8_LDA(At, 1, 0); PG8_STAGE(PG8_SA(0, 1), a2 + hstep, voffA);
            PG8_WAIT_V(8); PG8_WAIT_L(0); PG8_BAR; PG8_MMA(0, 0, At, B0); PG8_MMA(0, 1, At, B1); PG8_BAR; PG8_SCHED;
            PG8_LDA(At, 1, 1); PG8_STAGE(PG8_SB(1, 0), b3, voffB); PG8_STAGE(PG8_SB(1, 1), b3 + hstep, voffB); PG8_STAGE(PG8_SA(1, 0), a3, voffA);
            PG8_WAIT_V(8); PG8_WAIT_L(0); PG8_BAR; PG8_MMA(1, 0, At, B0); PG8_MMA(1, 1, At, B1); PG8_BAR; PG8_SCHED;
            } else {
            PG8_LDB(B0, 0, 0); PG8_SCHED; PG8_LDA(At, 0, 0); PG8_STAGE(PG8_SA(1, 1), a1 + hstep, voffA);
            PG8_WAIT_L(8); PG8_BAR; PG8_WAIT_L(0); PG8_MMA(0, 0, At, B0); PG8_BAR; PG8_SCHED;
            PG8_LDB(B1, 0, 1); PG8_STAGE(PG8_SB(0, 0), b2, voffB);
            PG8_BAR; PG8_WAIT_L(0); PG8_MMA(0, 1, At, B1); PG8_BAR;
            PG8_LDA(At, 0, 1); PG8_STAGE(PG8_SA(0, 0), a2, voffA);
            PG8_BAR; PG8_WAIT_L(0); PG8_MMA(1, 0, At, B0); PG8_BAR; PG8_SCHED;
            PG8_STAGE(PG8_SB(0, 1), b2 + hstep, voffB);
            PG8_WAIT_V(6); PG8_BAR; PG8_MMA(1, 1, At, B1); PG8_BAR;
            PG8_LDB(B0, 1, 0); PG8_SCHED; PG8_LDA(At, 1, 0); PG8_STAGE(PG8_SA(0, 1), a2 + hstep, voffA);
            PG8_WAIT_L(8); PG8_BAR; PG8_WAIT_L(0); PG8_MMA(0, 0, At, B0); PG8_BAR; PG8_SCHED;
            PG8_LDB(B1, 1, 1); PG8_STAGE(PG8_SB(1, 0), b3, voffB);
            PG8_BAR; PG8_WAIT_L(0); PG8_MMA(0, 1, At, B1); PG8_BAR;
            PG8_LDA(At, 1, 1); PG8_STAGE(PG8_SA(1, 0), a3, voffA);
            PG8_BAR; PG8_WAIT_L(0); PG8_MMA(1, 0, At, B0); PG8_BAR; PG8_SCHED;
            PG8_STAGE(PG8_SB(1, 1), b3 + hstep, voffB);
            PG8_WAIT_V(6); PG8_BAR; PG8_MMA(1, 1, At, B1); PG8_BAR;
            }
        }
        if constexpr (ALIGN_EPI) { if (wr == 0) PG8_BAR; }
        bool keep_acc = false;
        if constexpr (Epi::HAS_MID) { if (E.is_first_half(cur)) { E.mid(acc, cur, wr, wc, fr, fq); keep_acc = true; } else E(acc, cur, wr, wc, fr, fq); }
        else if constexpr (!Epi::AFTER_DRAIN) { E(acc, cur, wr, wc, fr, fq); S.done(cur); }
        if (!has_next) break;
        if (!keep_acc)
#pragma unroll
        for (int a = 0; a < 2; ++a)
#pragma unroll
            for (int b = 0; b < 2; ++b)
#pragma unroll
                for (int m = 0; m < 4; ++m)
#pragma unroll
                    for (int n = 0; n < 2; ++n) acc[a][b][m][n] = (f32x4){0.f, 0.f, 0.f, 0.f};
        cur = nxt; cA = nA; cB = nB; ++ui;
        if constexpr (ALIGN_EPI) { if (wr == 1) PG8_BAR; }
    }
    PG8_WAIT_V(0);
    if constexpr (!ALIGN_EPI) { if (wr == 0) PG8_BAR; }
    PG8_BAR;
    if constexpr (Epi::AFTER_DRAIN) { E.fused(acc, cur, wr, wc, fr, fq, lds, wid, lane); S.done(cur); }
#undef PG8_SA
#undef PG8_SB
#undef PG8_STAGE
#undef PG8_LDA
#undef PG8_LDB
#undef PG8_MMA
#undef PG8_WAIT_V
#undef PG8_WAIT_L
#undef PG8_BAR
#undef PG8_SCHED
}
}
#include <hip/hip_bf16.h>
#include <cmath>
namespace attn_body {
using bf16=__hip_bfloat16;
using bf16x8=__attribute__((ext_vector_type(8)))short;
using s16x4=__attribute__((ext_vector_type(4)))short;
using f32x16=__attribute__((ext_vector_type(16)))float;
using u32x4=__attribute__((ext_vector_type(4)))unsigned;
constexpr int BATCH=24,NHEAD=8,SEQ=2048,D=64,QP=512,KVP=256,OP=512;
constexpr int NW=8,QBLK=32,QB=QBLK*NW,KVBLK=64,NQB=SEQ/QB;
constexpr int ATTN_UNIT_ROWS=QB;
__device__ __forceinline__ int crow(int r,int hi){return (r&3)+8*(r>>2)+4*hi;}
#define SBAR() __builtin_amdgcn_sched_barrier(0)
__device__ __forceinline__ void cmask(f32x16&p0,f32x16&p1,int jb,int qrel,int hi){
  const float NEG=-INFINITY; int kb=64*jb+4*hi;
  #pragma unroll
  for(int r=0;r<16;++r){int kv=kb+(r&3)+8*(r>>2); if(kv>qrel)p0[r]=NEG; if(kv+32>qrel)p1[r]=NEG;}
}

constexpr int NSLOT=3, SLOTB=8192;
constexpr int LDS_K=0, LDS_V=NSLOT*SLOTB, LDS_WS=2*NSLOT*SLOTB, LDS_OST=LDS_WS+NW*64*4, LDS_BYTES=LDS_OST+NW*4096;
constexpr float C2=0.125f*1.4426950408889634f;
__device__ __forceinline__ void glds16(const void*gsrc,unsigned lds_dst){unsigned keep;
  asm volatile("s_mov_b32 %0, m0\n\ts_mov_b32 m0, %2\n\ts_nop 0\n\tglobal_load_lds_dwordx4 %1, off\n\ts_mov_b32 m0, %0":"=&s"(keep):"v"(gsrc),"s"(lds_dst):"memory");}
__device__ __forceinline__ float max3f(float a,float b,float c){float r;asm("v_max3_f32 %0, %1, %2, %3":"=v"(r):"v"(a),"v"(b),"v"(c));return r;}
__device__ __forceinline__ float max2f(float a,float b){float r;asm("v_max_f32_e32 %0, %1, %2":"=v"(r):"v"(a),"v"(b));return r;}
__device__ __forceinline__ float fadd_s(float a,float b){float r;asm("v_add_f32_e32 %0, %1, %2":"=v"(r):"v"(a),"v"(b));return r;}
__device__ __forceinline__ float fsub_s(float a,float b){float r;asm("v_sub_f32_e32 %0, %1, %2":"=v"(r):"v"(a),"v"(b));return r;}
typedef float f32x2_t __attribute__((ext_vector_type(2))); typedef __bf16 bf16x2_t __attribute__((ext_vector_type(2)));
__device__ __forceinline__ unsigned cvtpk_s(float lo,float hi){f32x2_t v={lo,hi};bf16x2_t b=__builtin_convertvector(v,bf16x2_t);return __builtin_bit_cast(unsigned,b);}
#define WAIT_BAR(N) asm volatile("s_waitcnt vmcnt(" #N ") lgkmcnt(0)\n\ts_barrier":::"memory")

__device__ __forceinline__ void qkt(f32x16&p0,f32x16&p1,const char*Kslot,const bf16x8*qr,const f32x16&negm,int r32,int hi){
  const char*kb=Kslot+hi*1024+r32*16;
  #pragma unroll
  for(int d0=0;d0<4;++d0){
    const bf16x8 b0=*reinterpret_cast<const bf16x8*>(kb+d0*2048);
    const bf16x8 b1=*reinterpret_cast<const bf16x8*>(kb+d0*2048+512);
    if(d0==0){p0=__builtin_amdgcn_mfma_f32_32x32x16_bf16(b0,qr[0],negm,0,0,0);p1=__builtin_amdgcn_mfma_f32_32x32x16_bf16(b1,qr[0],negm,0,0,0);}
    else{p0=__builtin_amdgcn_mfma_f32_32x32x16_bf16(b0,qr[d0],p0,0,0,0);p1=__builtin_amdgcn_mfma_f32_32x32x16_bf16(b1,qr[d0],p1,0,0,0);}}
}
typedef __attribute__((address_space(3))) const char* lds_cptr;
typedef short v4i16_t __attribute__((ext_vector_type(4)));
__device__ __forceinline__ void kload8(bf16x8*kf,lds_cptr kp){
  kf[0]=*(const __attribute__((address_space(3))) bf16x8*)(kp);      kf[1]=*(const __attribute__((address_space(3))) bf16x8*)(kp+512);
  kf[2]=*(const __attribute__((address_space(3))) bf16x8*)(kp+2048); kf[3]=*(const __attribute__((address_space(3))) bf16x8*)(kp+2560);
  kf[4]=*(const __attribute__((address_space(3))) bf16x8*)(kp+4096); kf[5]=*(const __attribute__((address_space(3))) bf16x8*)(kp+4608);
  kf[6]=*(const __attribute__((address_space(3))) bf16x8*)(kp+6144); kf[7]=*(const __attribute__((address_space(3))) bf16x8*)(kp+6656);
}
__device__ __forceinline__ void kload2(bf16x8*kf,lds_cptr kp,int j){ kf[2*j]=*(const __attribute__((address_space(3))) bf16x8*)(kp+j*2048); kf[2*j+1]=*(const __attribute__((address_space(3))) bf16x8*)(kp+j*2048+512); }
__device__ __forceinline__ s16x4 vtr(lds_cptr p){ return __builtin_bit_cast(s16x4,__builtin_amdgcn_ds_read_tr16_b64_v4i16((__attribute__((address_space(3))) v4i16_t*)p)); }
__device__ __forceinline__ float rowmax(const f32x16&p0,const f32x16&p1){
  float a=max3f(p0[0],p0[1],p1[0]),b=max3f(p0[2],p0[3],p1[1]);a=max3f(a,p1[2],p1[3]);
  #pragma unroll
  for(int r=4;r<16;r+=4){a=max3f(a,p0[r],p0[r+1]);b=max3f(b,p0[r+2],p0[r+3]);a=max3f(a,p1[r],p1[r+1]);b=max3f(b,p1[r+2],p1[r+3]);}
  const float m=max2f(a,b);
  auto rr=__builtin_amdgcn_permlane32_swap(__float_as_uint(m),__float_as_uint(m),false,false);
  return max2f(__uint_as_float(rr[0]),__uint_as_float(rr[1]));
}
__device__ __forceinline__ void pv(f32x16*o,int vb,bf16x8 pa0,bf16x8 pa1,bf16x8 pa2,bf16x8 pa3){
  #pragma unroll
  for(int d0=0;d0<2;++d0){s16x4 lo[4],hi[4];
    #pragma unroll
    for(int ks=0;ks<4;++ks){
      asm volatile("ds_read_b64_tr_b16 %0,%1 offset:%c2":"=&v"(lo[ks]):"v"(vb),"i"(d0*4096+ks*1024):"memory");
      asm volatile("ds_read_b64_tr_b16 %0,%1 offset:%c2":"=&v"(hi[ks]):"v"(vb),"i"(d0*4096+ks*1024+512):"memory");}
    asm volatile("s_waitcnt lgkmcnt(0)":::"memory");SBAR();
    #define PK(k) (bf16x8){lo[k][0],lo[k][1],lo[k][2],lo[k][3],hi[k][0],hi[k][1],hi[k][2],hi[k][3]}
    o[d0]=__builtin_amdgcn_mfma_f32_32x32x16_bf16(pa0,PK(0),o[d0],0,0,0);
    o[d0]=__builtin_amdgcn_mfma_f32_32x32x16_bf16(pa1,PK(1),o[d0],0,0,0);
    o[d0]=__builtin_amdgcn_mfma_f32_32x32x16_bf16(pa2,PK(2),o[d0],0,0,0);
    o[d0]=__builtin_amdgcn_mfma_f32_32x32x16_bf16(pa3,PK(3),o[d0],0,0,0);
    #undef PK
  }
}

#ifndef ATTN_STORE16
#define ATTN_STORE16(p,v) (*(u32x4*)(p)=(v))
#endif
template<int THRL> __device__ __forceinline__ void attn_unit(int b,int h,int qb,const bf16*Q,const bf16*__restrict__ K,const bf16*__restrict__ V,bf16*O,char*shm){
  int tid_l=threadIdx.x; asm volatile("":"+v"(tid_l)); const int tid=tid_l,lane=tid&63,r32=lane&31,hi=lane>>5; const int wid=__builtin_amdgcn_readfirstlane(tid>>6);
  const long rowbase=(long)b*SEQ; const int q0=qb*QB;
  const bf16*Qw=Q+(rowbase+q0+wid*QBLK)*QP+h*D;
  const bf16*Kh=K+rowbase*KVP+(h>>2)*D,*Vh=V+rowbase*KVP+(h>>2)*D;
  const unsigned lds0=(unsigned)(uintptr_t)shm;
  float*wsf=(float*)(shm+LDS_WS)+wid*64;
  const bf16*ksrc=Kh+(long)lane*KVP+wid*8;
  const bf16*vsrc=Vh+(long)(16*(wid&3)+(lane>>2))*KVP+(wid>>2)*32+(lane&3)*8;
  const unsigned kdst=lds0+LDS_K+wid*1024, vdst=lds0+LDS_V+wid*1024;
  #define DMA_K(t,slot) glds16(ksrc+(long)(t)*KVBLK*KVP,(unsigned)__builtin_amdgcn_readfirstlane(kdst+(slot)))
  #define DMA_V(t,slot) glds16(vsrc+(long)(t)*KVBLK*KVP,(unsigned)__builtin_amdgcn_readfirstlane(vdst+(slot)))
  const int vb0=(int)(lds0+LDS_V)+((lane>>4)&1)*32+(lane&3)*8+(4*hi+((lane&15)>>2))*64;
  const char*Kbase=shm+LDS_K; bf16x8 kf[8];
  const lds_cptr shm3=(lds_cptr)shm; const lds_cptr kp0=shm3+LDS_K+hi*1024+r32*16; const lds_cptr vp0=shm3+LDS_V+((lane>>4)&1)*32+(lane&3)*8+(4*hi+((lane&15)>>2))*64;
  const int NT=SEQ/KVBLK;
  DMA_K(0,0);DMA_V(0,0);DMA_K(1,SLOTB);
  bf16x8 qr[4];
  #pragma unroll
  for(int d0=0;d0<4;++d0)qr[d0]=*reinterpret_cast<const bf16x8*>(&Qw[(long)r32*QP+d0*16+hi*8]);
  float mhat=0.f,l_reg=0.f;f32x16 o[2];o[0]=f32x16{};o[1]=f32x16{};f32x16 negm=f32x16{};asm volatile("":"+v"(negm));
  const int qrel=wid*QBLK+r32;
  #define CMASK(P0,P1,t) do{}while(0)
  bool resc=false;
  #define START(P0,P1) do{ const float rm=rowmax(P0,P1); resc=false; \
    { const float dl=rm; mhat=fadd_s(mhat,dl); \
      _Pragma("unroll") for(int r=0;r<16;++r){P0[r]=fsub_s(P0[r],dl);P1[r]=fsub_s(P1[r],dl);} \
      _Pragma("unroll") for(int r=0;r<16;++r)negm[r]=-mhat; asm volatile("":"+v"(negm)); } \
    _Pragma("unroll") for(int r=0;r<16;++r)P0[r]=__builtin_amdgcn_exp2f(P0[r]); }while(0)
  #define RESC() do{ if(resc){ asm volatile("s_waitcnt lgkmcnt(0)":::"memory"); \
      _Pragma("unroll") for(int d_=0;d_<2;++d_) _Pragma("unroll") for(int r=0;r<16;++r)o[d_][r]*=wsf[crow(r,hi)]; } }while(0)
  f32x16 pA0,pA1,pB0,pB1;
  int sl_prev=0,sl_cur=0,sl_next=SLOTB;
  #define ROT() do{sl_prev=sl_cur;sl_cur=sl_next;sl_next=(sl_next==(NSLOT-1)*SLOTB)?0:sl_next+SLOTB;}while(0)
  DMA_K(2,2*SLOTB);
  WAIT_BAR(3);
  qkt(pA0,pA1,Kbase,qr,negm,r32,hi);asm volatile("s_nop 15\n\ts_nop 7":"+v"(pA0),"+v"(pA1));CMASK(pA0,pA1,0);
  START(pA0,pA1);
  _Pragma("unroll") for(int r=0;r<16;++r)pA1[r]=__builtin_amdgcn_exp2f(pA1[r]);
  WAIT_BAR(0);
  DMA_K(3,0);DMA_V(1,SLOTB);
  ROT();
  kload8(kf,kp0+sl_cur);
  WAIT_BAR(2);
  s16x4 vlo[8],vhi[8]; u32x4 pw0,pw1,pw2,pw3;
  #define PKW(P,B) cvtpk_s(P[B],P[B+1])
  #define PAF(k) __builtin_bit_cast(bf16x8,pw##k)
  #define VFR(i) (bf16x8){vlo[i][0],vlo[i][1],vlo[i][2],vlo[i][3],vhi[i][0],vhi[i][1],vhi[i][2],vhi[i][3]}
  #define PIN(x) asm volatile("":"+v"(x))
  #define MX3(a,b,c) __builtin_fmaxf(__builtin_fmaxf((a),(b)),(c))
  #define GAPA(MF,A0,A1,A2,A3,W0,W1,PW) do{ MF; sacc+=A0; sacc+=A1; sacc+=A2; sacc+=A3; PIN(sacc); W0; W1; PIN(PW); SBAR(); }while(0)
  #define EX(v) __builtin_amdgcn_exp2f(v)
  #define GAPB(MF,X,B) do{ MF; X[B]=EX(X[B]); X[B+1]=EX(X[B+1]); X[B+2]=EX(X[B+2]); X[B+3]=EX(X[B+3]); PIN(X); SBAR(); }while(0)
  #define VRD(i) do{ vlo[i]=vtr(vp_+(((i)>>2)*4096+((i)&3)*1024)); vhi[i]=vtr(vp_+(((i)>>2)*4096+((i)&3)*1024+512)); }while(0)
  #define KRD(G,j) do{ if(G){ kload2(kf,kp0+sl_next,j); SBAR(); } }while(0)
  #define STEP(C0,C1,P0,P1,t,GK,GV,GL) do{ SBAR(); \
    const lds_cptr vp_=vp0+sl_prev; \
    VRD(0); SBAR(); float sacc=(P0[0]+P0[1]); \
    GAPA(C0=__builtin_amdgcn_mfma_f32_32x32x16_bf16(kf[0],qr[0],negm,0,0,0), P0[2],P0[3],P0[4],P0[5],     pw0[0]=PKW(P0,0), pw0[1]=PKW(P0,2), pw0); \
    VRD(4); SBAR(); GAPA(C1=__builtin_amdgcn_mfma_f32_32x32x16_bf16(kf[1],qr[0],negm,0,0,0), P0[6],P0[7],P0[8],P0[9],     pw0[2]=PKW(P0,4), pw0[3]=PKW(P0,6), pw0); \
    VRD(1); SBAR(); GAPA(C0=__builtin_amdgcn_mfma_f32_32x32x16_bf16(kf[2],qr[1],C0,0,0,0),   P0[10],P0[11],P0[12],P0[13], pw1[0]=PKW(P0,8), pw1[1]=PKW(P0,10), pw1); \
    VRD(5); SBAR(); GAPA(C1=__builtin_amdgcn_mfma_f32_32x32x16_bf16(kf[3],qr[1],C1,0,0,0),   P0[14],P0[15],P1[0],P1[1],   pw1[2]=PKW(P0,12),pw1[3]=PKW(P0,14), pw1); \
    VRD(2); SBAR(); GAPA(C0=__builtin_amdgcn_mfma_f32_32x32x16_bf16(kf[4],qr[2],C0,0,0,0),   P1[2],P1[3],P1[4],P1[5],     pw2[0]=PKW(P1,0), pw2[1]=PKW(P1,2), pw2); \
    VRD(6); SBAR(); GAPA(C1=__builtin_amdgcn_mfma_f32_32x32x16_bf16(kf[5],qr[2],C1,0,0,0),   P1[6],P1[7],P1[8],P1[9],     pw2[2]=PKW(P1,4), pw2[3]=PKW(P1,6), pw2); \
    VRD(3); SBAR(); GAPA(C0=__builtin_amdgcn_mfma_f32_32x32x16_bf16(kf[6],qr[3],C0,0,0,0),   P1[10],P1[11],P1[12],P1[13], pw3[0]=PKW(P1,8), pw3[1]=PKW(P1,10), pw3); \
    VRD(7); SBAR(); GAPA(C1=__builtin_amdgcn_mfma_f32_32x32x16_bf16(kf[7],qr[3],C1,0,0,0),   P1[14],P1[15],0.f,0.f,       pw3[2]=PKW(P1,12),pw3[3]=PKW(P1,14), pw3); \
    l_reg+=sacc; \
    if(GK){DMA_K((t)+3,sl_cur);} if(GV){DMA_V((t)+1,sl_next);} \
    CMASK(C0,C1,t); \
    { float a=MX3(C0[0],C0[1],C1[0]),b=MX3(C0[2],C0[3],C1[1]); a=MX3(a,C1[2],C1[3]); \
      _Pragma("unroll") for(int r=4;r<16;r+=4){a=MX3(a,C0[r],C0[r+1]);b=MX3(b,C0[r+2],C0[r+3]);a=MX3(a,C1[r],C1[r+1]);b=MX3(b,C1[r+2],C1[r+3]);} \
      float rm=__builtin_fmaxf(a,b); { auto rr=__builtin_amdgcn_permlane32_swap(__float_as_uint(rm),__float_as_uint(rm),false,false); rm=__builtin_fmaxf(__uint_as_float(rr[0]),__uint_as_float(rr[1])); } \
      resc=false; \
      if(__builtin_expect(__any(rm>(float)THRL),0)){ const float dl=__builtin_fmaxf(rm,0.f); mhat+=dl; \
        _Pragma("unroll") for(int r=0;r<16;++r){C0[r]-=dl;C1[r]-=dl;} \
        _Pragma("unroll") for(int r=0;r<16;++r)negm[r]=-mhat; asm volatile("":"+v"(negm)); \
        const float f=__builtin_amdgcn_exp2f(-dl); l_reg*=f; if(hi==0)wsf[r32]=f; resc=true; } } \
    SBAR(); \
    GAPB(o[0]=__builtin_amdgcn_mfma_f32_32x32x16_bf16(PAF(0),VFR(0),o[0],0,0,0), C0,0); \
    GAPB(o[1]=__builtin_amdgcn_mfma_f32_32x32x16_bf16(PAF(0),VFR(4),o[1],0,0,0), C0,4); \
    KRD(GL,0); GAPB(o[0]=__builtin_amdgcn_mfma_f32_32x32x16_bf16(PAF(1),VFR(1),o[0],0,0,0), C0,8); \
    KRD(GL,1); GAPB(o[1]=__builtin_amdgcn_mfma_f32_32x32x16_bf16(PAF(1),VFR(5),o[1],0,0,0), C0,12); \
    KRD(GL,2); GAPB(o[0]=__builtin_amdgcn_mfma_f32_32x32x16_bf16(PAF(2),VFR(2),o[0],0,0,0), C1,0); \
    KRD(GL,3); GAPB(o[1]=__builtin_amdgcn_mfma_f32_32x32x16_bf16(PAF(2),VFR(6),o[1],0,0,0), C1,4); \
    GAPB(o[0]=__builtin_amdgcn_mfma_f32_32x32x16_bf16(PAF(3),VFR(3),o[0],0,0,0), C1,8); \
    GAPB(o[1]=__builtin_amdgcn_mfma_f32_32x32x16_bf16(PAF(3),VFR(7),o[1],0,0,0), C1,12); \
    }while(0)
  int t=1;
  #undef CMASK
  #define CMASK(P0,P1,t) do{}while(0)
  for(;t+5<NT;t+=2){
    STEP(pB0,pB1,pA0,pA1,t,true,true,true);     WAIT_BAR(2); RESC(); ROT();
    STEP(pA0,pA1,pB0,pB1,t+1,true,true,true);   WAIT_BAR(2); RESC(); ROT();
  }
  #undef CMASK
  #define CMASK(P0,P1,t) do{}while(0)
  #define ENDW(tt) do{ if((tt)+3<NT){WAIT_BAR(2);} else if((tt)+2<NT){WAIT_BAR(1);} else {WAIT_BAR(0);} }while(0)
  for(;t+1<NT;t+=2){
    STEP(pB0,pB1,pA0,pA1,t,(t+3<NT),(t+1<NT),(t+1<NT));       ENDW(t);   RESC(); ROT();
    STEP(pA0,pA1,pB0,pB1,t+1,(t+4<NT),(t+2<NT),(t+2<NT));     ENDW(t+1); RESC(); ROT();
  }
  STEP(pB0,pB1,pA0,pA1,NT-1,false,false,false); RESC();
  { float sacc=pB0[0]+pB0[1]; _Pragma("unroll") for(int r=2;r<16;++r)sacc+=pB0[r]; _Pragma("unroll") for(int r=0;r<16;++r)sacc+=pB1[r]; l_reg+=sacc;
    pw0=(u32x4){PKW(pB0,0),PKW(pB0,2),PKW(pB0,4),PKW(pB0,6)};pw1=(u32x4){PKW(pB0,8),PKW(pB0,10),PKW(pB0,12),PKW(pB0,14)};pw2=(u32x4){PKW(pB1,0),PKW(pB1,2),PKW(pB1,4),PKW(pB1,6)};pw3=(u32x4){PKW(pB1,8),PKW(pB1,10),PKW(pB1,12),PKW(pB1,14)};
    SBAR(); pv(o,vb0+sl_cur,PAF(0),PAF(1),PAF(2),PAF(3)); }
  #undef PKW
  #undef PAF
  #undef VFR
  #undef PIN
  #undef MX3
  #undef GAPA
  #undef GAPB
  #undef EX
  #undef VRD
  #undef KRD
  #undef STEP
  #undef ENDW
  {auto rr=__builtin_amdgcn_permlane32_swap(__float_as_uint(l_reg),__float_as_uint(l_reg),false,false);l_reg=__uint_as_float(rr[0])+__uint_as_float(rr[1]);}
  if(hi==0)wsf[32+r32]=l_reg;asm volatile("s_waitcnt lgkmcnt(0)":::"memory");
  float rli[16];
  #pragma unroll
  for(int r=0;r<16;++r)rli[r]=__builtin_amdgcn_rcpf(wsf[32+crow(r,hi)]);
  bf16*Ow=O+(rowbase+q0+wid*QBLK)*OP+h*D;
  { bf16*stg=(bf16*)(shm+LDS_OST)+wid*2048;
    #pragma unroll
    for(int r=0;r<16;++r){const int orow=crow(r,hi);
      #pragma unroll
      for(int d0=0;d0<2;++d0)stg[orow*64+d0*32+r32]=__float2bfloat16(o[d0][r]*rli[r]);}
    asm volatile("s_waitcnt lgkmcnt(0)":::"memory");
    #pragma unroll
    for(int i=0;i<4;++i){const int row=i*8+(lane>>3),ch=lane&7; const u32x4 v=*(const u32x4*)(stg+row*64+ch*8); ATTN_STORE16(Ow+(long)row*OP+ch*8,v);} }
  asm volatile("s_waitcnt lgkmcnt(0)\n\ts_barrier":::"memory");
  #undef DMA_K
  #undef DMA_V
  #undef CMASK
  #undef START
  #undef RESC
  #undef ROT
}
constexpr int ATTN_LDS_BYTES=LDS_BYTES;
#undef SBAR
#undef WAIT_BAR
}
namespace cg = cooperative_groups;
#define GAS __attribute__((address_space(1)))
#define LAS __attribute__((address_space(3)))
typedef unsigned short bf16;
typedef unsigned v4u __attribute__((ext_vector_type(4)));
typedef unsigned v2u __attribute__((ext_vector_type(2)));
typedef float f32x4 __attribute__((ext_vector_type(4)));
typedef float f32x16 __attribute__((ext_vector_type(16)));
typedef short bf16x8 __attribute__((ext_vector_type(8)));
constexpr int NWAVES = 8;
constexpr int T = 49152, SEQ = 2048, NB = 24, DM = 1024, DFF = 2816, DIN = 4880;
constexpr float EPS = 1e-6f, LOG2E = 1.4426950408889634f;
constexpr size_t MiB = 1u << 20;
constexpr size_t WS_CTL = 0, CTL_ZERO_BYTES = 65536;
constexpr int CW_BAR = 4096;
constexpr size_t WS_ROPEC = 1 * MiB, WS_ROPES = WS_ROPEC + 256 * 1024;
constexpr size_t WS_SS0 = 1 * MiB + 512 * 1024, WS_SS1 = WS_SS0 + 256 * 1024, WS_SS2 = WS_SS1 + 256 * 1024, WS_SS3 = WS_SS2 + 256 * 1024;
constexpr size_t WS_WOLD = 2 * MiB + 512 * 1024;
constexpr size_t WS_G16 = 3 * MiB, WS_SC = 6 * MiB, WS_DEN = 14 * MiB;
constexpr size_t WS_W1GU = 16 * MiB, WS_W1D = 27 * MiB, WS_WIN = 33 * MiB, WS_WA = 43 * MiB, WS_WM = 44 * MiB, WS_WOUT = 45 * MiB, WS_W2GU = 47 * MiB, WS_W2D = 58 * MiB;
constexpr size_t WS_XB = 64 * MiB, WS_H = 160 * MiB;
constexpr size_t WS_QB = 160 * MiB, WS_KV = 208 * MiB, WS_MQK = 232 * MiB, WS_NUM = 328 * MiB, WS_OPRE = 424 * MiB, WS_MEM = 232 * MiB, WS_MERGED = 328 * MiB, WS_SCF = 472 * MiB, WS_END = 480 * MiB;
constexpr size_t OUT_AM = 96 * MiB, WS_GA = 160 * MiB;
constexpr int RING_BYTES = 131072, MISC_OFF = 140288, LDS_BYTES = 147456;
constexpr int ML_BUF = 66560;
constexpr int N_MLSTM_BLK = 192, N_ATT_UNITS = 1536;

struct Args { const float* in[20]; float* out; unsigned char* ws; };

__device__ __forceinline__ unsigned f2bf(float f) { unsigned u = __builtin_bit_cast(unsigned, f); return (u + 0x7fffu + ((u >> 16) & 1u)) >> 16; }
__device__ __forceinline__ unsigned pk2(float lo, float hi) { return f2bf(lo) | (f2bf(hi) << 16); }
__device__ __forceinline__ float bflo(unsigned w) { return __uint_as_float(w << 16); }
__device__ __forceinline__ float bfhi(unsigned w) { return __uint_as_float(w & 0xffff0000u); }
__device__ __forceinline__ float wave_sum(float v) {
#pragma unroll
    for (int o = 1; o < 64; o <<= 1) v += __shfl_xor(v, o);
    return v;
}
#define LDS_WAIT() asm volatile("s_waitcnt lgkmcnt(0)" ::: "memory")

struct Seg { const float* W; int ldw, K, c0, nc; bf16* dst; int drow0; const float* gain; float cs; int map; int ldk, koff; };
__device__ __forceinline__ int seg_items(const Seg& s) { return (s.K / 64) * ((s.nc + 31) / 32); }
__device__ __forceinline__ Seg get_seg(int i, const Args& a) {
    unsigned char* ws = a.ws; Seg s; s.gain = nullptr; s.cs = 1.f; s.map = 0; s.c0 = 0; s.drow0 = 0; s.ldk = 0; s.koff = 0;
    bf16* WIN = (bf16*)(ws + WS_WIN);
    switch (i) {
    case 0: s.W = a.in[3]; s.ldw = DFF; s.K = DM; s.nc = DFF; s.dst = (bf16*)(ws + WS_W1GU); s.gain = a.in[2]; s.map = 1; break;
    case 1: s.W = a.in[4]; s.ldw = DFF; s.K = DM; s.nc = DFF; s.dst = (bf16*)(ws + WS_W1GU); s.drow0 = 128; s.gain = a.in[2]; s.map = 1; break;
    case 2: s.W = a.in[5]; s.ldw = DM; s.K = DFF; s.nc = DM; s.dst = (bf16*)(ws + WS_W1D); s.cs = 0.5f; break;
    case 3: s.W = a.in[16]; s.ldw = DFF; s.K = DM; s.nc = DFF; s.dst = (bf16*)(ws + WS_W2GU); s.gain = a.in[15]; s.map = 1; break;
    case 4: s.W = a.in[17]; s.ldw = DFF; s.K = DM; s.nc = DFF; s.dst = (bf16*)(ws + WS_W2GU); s.drow0 = 128; s.gain = a.in[15]; s.map = 1; break;
    case 5: s.W = a.in[18]; s.ldw = DM; s.K = DFF; s.nc = DM; s.dst = (bf16*)(ws + WS_W2D); s.cs = 0.5f; break;
    case 6: s.W = a.in[7]; s.ldw = DIN; s.K = DM; s.c0 = 0; s.nc = 512; s.dst = WIN; s.drow0 = 0; s.gain = a.in[6]; s.map = 2; break;
    case 7: s.W = a.in[7]; s.ldw = DIN; s.K = DM; s.c0 = 512; s.nc = 128; s.dst = WIN; s.drow0 = 512; s.gain = a.in[6]; s.map = 3; break;
    case 8: s.W = a.in[7]; s.ldw = DIN; s.K = DM; s.c0 = 640; s.nc = 128; s.dst = WIN; s.drow0 = 512; s.gain = a.in[6]; s.map = 4; break;
    case 9: s.W = a.in[7]; s.ldw = DIN; s.K = DM; s.c0 = 768; s.nc = 512; s.dst = WIN; s.drow0 = 768; s.gain = a.in[6]; break;
    case 10: s.W = a.in[7]; s.ldw = DIN; s.K = DM; s.c0 = 2304; s.nc = 16; s.dst = WIN; s.drow0 = 1280; s.gain = a.in[6]; break;
    case 11: s.W = a.in[7]; s.ldw = DIN; s.K = DM; s.c0 = 2320; s.nc = 512; s.dst = WIN; s.drow0 = 1536; s.gain = a.in[6]; break;
    case 12: s.W = a.in[7]; s.ldw = DIN; s.K = DM; s.c0 = 1280; s.nc = 512; s.dst = WIN; s.drow0 = 2048; s.gain = a.in[6]; s.cs = 0.08838834764831845f; break;
    case 13: s.W = a.in[7]; s.ldw = DIN; s.K = DM; s.c0 = 1792; s.nc = 512; s.dst = WIN; s.drow0 = 2560; s.gain = a.in[6]; break;
    case 14: s.W = a.in[7]; s.ldw = DIN; s.K = DM; s.c0 = 2832; s.nc = 1024; s.dst = WIN; s.drow0 = 3072; s.gain = a.in[6]; break;
    case 15: s.W = a.in[7]; s.ldw = DIN; s.K = DM; s.c0 = 3856; s.nc = 1024; s.dst = WIN; s.drow0 = 4096; s.gain = a.in[6]; break;
    case 16: s.W = a.in[12]; s.ldw = DM; s.K = 512; s.nc = DM; s.dst = (bf16*)(ws + WS_WA); break;
    case 17: s.W = a.in[13]; s.ldw = DM; s.K = 512; s.nc = DM; s.dst = (bf16*)(ws + WS_WM); break;
    default: s.W = a.in[14]; s.ldw = DM; s.K = DM; s.nc = DM; s.dst = (bf16*)(ws + WS_WOUT); break;
    }
    if (s.ldk == 0) s.ldk = s.K;
    return s;
}
constexpr int NSEG = 19;
__device__ __forceinline__ void tr_item(const Seg& s, int item, LAS float* scr, int lane) {
    const int nblk = (s.nc + 31) / 32, kb = item / nblk, nb = item % nblk, k0 = 64 * kb, cb = 32 * nb;
    const int nv = (s.nc - cb) < 32 ? (s.nc - cb) : 32;
    const int c = lane & 31, c8 = lane & 7;
    float v[32];
    const float* src = s.W + (size_t)(k0 + (lane >> 5)) * s.ldw + s.c0 + cb + (c < nv ? c : 0);
#pragma unroll
    for (int i = 0; i < 32; ++i) v[i] = src[(size_t)(2 * i) * s.ldw];
    f32x4 g0 = (f32x4){1.f, 1.f, 1.f, 1.f}, g1 = g0;
    if (s.gain) { g0 = *(const f32x4*)(s.gain + k0 + 8 * c8); g1 = *(const f32x4*)(s.gain + k0 + 8 * c8 + 4); }
    g0 = g0 * s.cs; g1 = g1 * s.cs;
#pragma unroll
    for (int i = 0; i < 32; ++i) scr[(2 * i + (lane >> 5)) * 33 + c] = v[i];
    LDS_WAIT(); asm volatile("" ::: "memory");
    int drow = s.drow0 + cb;
    if (s.map == 1) drow = s.drow0 + 256 * (cb / 128) + (cb % 128);
    else if (s.map == 2) drow = (cb >> 8) * 256 + ((cb & 63) >> 5) * 128 + ((cb >> 6) & 3) * 32;
    else if (s.map == 3) drow = 512 + ((cb & 63) >> 5) * 128 + (cb >> 6) * 32;
    else if (s.map == 4) drow = 512 + (cb < 64 ? 64 + cb : 192 + (cb - 64));
#pragma unroll
    for (int j = 0; j < 4; ++j) { const int n = (lane >> 3) + 8 * j; const LAS float* sp = scr + (8 * c8) * 33 + n;
        v4u o; o.x = pk2(sp[0 * 33] * g0[0], sp[1 * 33] * g0[1]); o.y = pk2(sp[2 * 33] * g0[2], sp[3 * 33] * g0[3]); o.z = pk2(sp[4 * 33] * g1[0], sp[5 * 33] * g1[1]); o.w = pk2(sp[6 * 33] * g1[2], sp[7 * 33] * g1[3]);
        if (n < nv) *(v4u*)(s.dst + (size_t)(drow + n) * s.ldk + s.koff + k0 + 8 * c8) = o; }
    LDS_WAIT(); asm volatile("" ::: "memory");
}
__device__ __forceinline__ void p0_prologue(const Args& a, LAS unsigned char* lds, int gw, int NGW, int wave, int lane_in) {
    int lane = lane_in; asm volatile("" : "+v"(lane));
    LAS float* scr = (LAS float*)(lds + wave * 16384);
    int total = 0;
    for (int i = 0; i < NSEG; ++i) { const Seg s = get_seg(i, a); total += seg_items(s); }
    for (int it = gw; it < total; it += NGW) {
        int r = it, si = 0; Seg s = get_seg(0, a);
        for (;;) { const int n = seg_items(s); if (r < n) break; r -= n; ++si; s = get_seg(si, a); }
        tr_item(s, r, scr, lane);
    }
    { v4u* z = (v4u*)((bf16*)(a.ws + WS_WIN) + (size_t)1296 * DM); const int n16 = 240 * DM * 2 / 16;
      for (int i = gw * 64 + lane; i < n16; i += NGW * 64) z[i] = (v4u){0u, 0u, 0u, 0u}; }
    { float* rc = (float*)(a.ws + WS_ROPEC); float* rs = (float*)(a.ws + WS_ROPES);
      for (int i = gw * 64 + lane; i < SEQ * 32; i += NGW * 64) { const int pos = i >> 5, j = i & 31; const float invf = powf(10000.0f, -(float)(2 * (j & 15)) / 32.0f);
          const float ang = (float)(j < 16 ? (pos >> 6) : (pos & 63)) * invf; float sn, cs; sincosf(ang, &sn, &cs); rc[i] = cs; rs[i] = sn; } }
    bf16* XB = (bf16*)(a.ws + WS_XB); float* SS0 = (float*)(a.ws + WS_SS0); float* SS1 = (float*)(a.ws + WS_SS1); float* SS2 = (float*)(a.ws + WS_SS2); float* SS3 = (float*)(a.ws + WS_SS3);
    for (int m0 = gw * 2; m0 < T; m0 += NGW * 2) {
        f32x4 v[2][4]; float s[2];
#pragma unroll
        for (int r = 0; r < 2; ++r) { const int m = m0 + r; const float* xrow = (m < 16384 ? a.in[0] + (size_t)m * DM : a.in[1] + (size_t)(m - 16384) * DM);
            const f32x4* xr = (const f32x4*)xrow + lane;
#pragma unroll
            for (int j = 0; j < 4; ++j) v[r][j] = xr[64 * j]; }
#pragma unroll
        for (int r = 0; r < 2; ++r) { const int m = m0 + r; float ss = 0.f;
#pragma unroll
            for (int j = 0; j < 4; ++j) ss += (v[r][j].x * v[r][j].x + v[r][j].y * v[r][j].y) + (v[r][j].z * v[r][j].z + v[r][j].w * v[r][j].w);
            s[r] = wave_sum(ss);
            v2u* o8 = (v2u*)(XB + (size_t)m * DM) + lane;
#pragma unroll
            for (int j = 0; j < 4; ++j) o8[64 * j] = (v2u){pk2(v[r][j].x, v[r][j].y), pk2(v[r][j].z, v[r][j].w)};
            if (lane == 0) { SS0[m] = s[r]; SS1[m] = 0.f; SS2[m] = 0.f; SS3[m] = 0.f; } }
    }
}

__device__ __forceinline__ float logsigmoid(float x) { return fminf(x, 0.f) - log1pf(expf(-fabsf(x))); }
__device__ __forceinline__ void gate_scan_item(const Args& a, int item, int lane) {
    unsigned char* ws = a.ws;
    const float* G16 = (const float*)(ws + WS_G16); const float* bias = a.in[10];
    float* SC = (float*)(ws + WS_SC); float* WOLD = (float*)(ws + WS_WOLD);
    {
        const int dir = item & 1, h = (item >> 1) & 3, b = item >> 3;
        const float bi = bias[(2 * dir) * 4 + h], bf_ = bias[(2 * dir + 1) * 4 + h];
        float* sc = SC + (size_t)item * 5 * SEQ;
        float mrun = 0.f;
        float liv[32], lfv[32];
#pragma unroll
        for (int c = 0; c < 32; ++c) { const int t = dir ? (SEQ - 1 - (64 * c + lane)) : (64 * c + lane); const float* g = G16 + (size_t)(b * SEQ + t) * 16;
            liv[c] = g[(2 * dir) * 4 + h]; lfv[c] = g[(2 * dir + 1) * 4 + h]; }
#pragma unroll
        for (int c = 0; c < 32; ++c) {
            const int t = dir ? (SEQ - 1 - (64 * c + lane)) : (64 * c + lane);
            const float li = liv[c] + bi; const float lf = logsigmoid(lfv[c] + bf_);
            float bj = lf;
#pragma unroll
            for (int o = 1; o < 64; o <<= 1) { const float n = __shfl_up(bj, o); if (lane >= o) bj += n; }
            const float av = li - bj; float pm = av;
#pragma unroll
            for (int o = 1; o < 64; o <<= 1) { const float n = __shfl_up(pm, o); if (lane >= o) pm = fmaxf(pm, n); }
            const float Mx = fmaxf(mrun, pm);
            const float Mc = __shfl(Mx, 63), bL = __shfl(bj, 63);
            sc[0 * SEQ + t] = expf(Mc - Mx); sc[1 * SEQ + t] = Mx * LOG2E; sc[2 * SEQ + t] = expf(mrun - Mx); sc[3 * SEQ + t] = expf(-(bj + Mx)); sc[4 * SEQ + t] = expf(av - Mc);
            if (lane == 0) WOLD[item * 32 + c] = expf(mrun - Mc);
            { float* scf = (float*)(ws + WS_SCF) + (size_t)(item * 32 + (t >> 6)) * 256 + (t & 63);
              scf[0] = expf(Mc - Mx); scf[64] = expf(mrun - Mx); scf[128] = expf(av - Mc); scf[192] = expf(mrun - Mc); }
            mrun = bL + Mc;
        }
    }
}
__device__ __forceinline__ void p3b(const Args& a, int gw, int NGW, int lane_in) {
    int lane = lane_in; asm volatile("" : "+v"(lane));
    unsigned char* ws = a.ws;
    bf16* QB = (bf16*)(ws + WS_QB); bf16* KV = (bf16*)(ws + WS_KV);
    const float* rc = (const float*)(ws + WS_ROPEC); const float* rs = (const float*)(ws + WS_ROPES);
    const float* qn = a.in[8]; const float* kn = a.in[9];
    const int j = lane & 31; const float C2 = 0.125f * LOG2E;
    const float qw0 = qn[2 * j], qw1 = qn[2 * j + 1], kw0 = kn[2 * j], kw1 = kn[2 * j + 1];
    for (int m0 = gw * 2; m0 < T; m0 += NGW * 2) {
        unsigned w[2][5]; float cs[2], sn[2];
#pragma unroll
        for (int r = 0; r < 2; ++r) { const int m = m0 + r; const int pos = m & (SEQ - 1); cs[r] = rc[pos * 32 + j]; sn[r] = rs[pos * 32 + j];
#pragma unroll
            for (int i = 0; i < 5; ++i) { const int hh = 2 * i + (lane >> 5);
                const unsigned* p = (hh < 8) ? (const unsigned*)(QB + (size_t)m * 512 + hh * 64 + 2 * j) : (const unsigned*)(KV + (size_t)m * 256 + (hh - 8) * 64 + 2 * j);
                w[r][i] = *p; } }
        asm volatile("" ::: "memory");
#pragma unroll
        for (int r = 0; r < 2; ++r) { const int m = m0 + r;
#pragma unroll
            for (int i = 0; i < 5; ++i) { const int hh = 2 * i + (lane >> 5);
                unsigned* p = (hh < 8) ? (unsigned*)(QB + (size_t)m * 512 + hh * 64 + 2 * j) : (unsigned*)(KV + (size_t)m * 256 + (hh - 8) * 64 + 2 * j);
                const float n0 = (hh < 8) ? qw0 : kw0, n1 = (hh < 8) ? qw1 : kw1, scl = (hh < 8) ? C2 : 1.0f;
                const float x0 = bflo(w[r][i]), x1 = bfhi(w[r][i]);
                float ss = x0 * x0 + x1 * x1;
#pragma unroll
                for (int o = 1; o < 32; o <<= 1) ss += __shfl_xor(ss, o);
                const float rinv = rsqrtf(ss * (1.0f / 64.0f) + EPS);
                const float y0 = x0 * rinv * n0, y1 = x1 * rinv * n1;
                *p = pk2((y0 * cs[r] - y1 * sn[r]) * scl, (y0 * sn[r] + y1 * cs[r]) * scl); } }
    }
}

__device__ __forceinline__ int sigma32(int r) { return (r & 19) | ((r & 4) << 1) | ((r & 8) >> 1); }
__device__ __forceinline__ unsigned cvtpk(float lo, float hi) { unsigned r; asm volatile("v_cvt_pk_bf16_f32 %0, %1, %2" : "=v"(r) : "v"(lo), "v"(hi)); return r; }
#define MFMA_GUARD1(X) asm volatile("s_nop 15\n\ts_nop 7" : "+v"(X))
#define MFMA32(A, B, Cc) __builtin_amdgcn_mfma_f32_32x32x16_bf16(A, B, Cc, 0, 0, 0)
#define CBAR() asm volatile("" ::: "memory")
template <int DIR, bool DIAG> __device__ __forceinline__ void mask_tile(const f32x16& Sin, int tl, int hh, bf16x8& P0, bf16x8& P1) {
    f32x16 S = Sin; MFMA_GUARD1(S);
    unsigned pw[8];
#pragma unroll
    for (int g = 0; g < 16; g += 2) {
        float p0 = S[g], p1 = S[g + 1];
        if (DIAG) { const int s0 = (g & 7) + 8 * hh + 16 * (g >> 3);
            const bool v0 = DIR ? (s0 >= tl) : (s0 <= tl), v1 = DIR ? (s0 + 1 >= tl) : (s0 + 1 <= tl);
            p0 = v0 ? p0 : 0.f; p1 = v1 ? p1 : 0.f; }
        pw[g >> 1] = cvtpk(p0, p1);
    }
    P0 = __builtin_bit_cast(bf16x8, (v4u){pw[0], pw[1], pw[2], pw[3]}); P1 = __builtin_bit_cast(bf16x8, (v4u){pw[4], pw[5], pw[6], pw[7]});
}
#define CFRAG(ks) ({ const int dt_ = (ks) >> 1, s2_ = (ks) & 1; v4u w_; \
        w_.x = cvtpk(C[dt_][8 * s2_ + 0], C[dt_][8 * s2_ + 1]); w_.y = cvtpk(C[dt_][8 * s2_ + 2], C[dt_][8 * s2_ + 3]); \
        w_.z = cvtpk(C[dt_][8 * s2_ + 4], C[dt_][8 * s2_ + 5]); w_.w = cvtpk(C[dt_][8 * s2_ + 6], C[dt_][8 * s2_ + 7]); __builtin_bit_cast(bf16x8, w_); })
#define STORE_NUM(PV, QC, FC, WI, TT) do { const size_t row_ = (size_t)b * SEQ + t0 + 32 * (TT) + tl; \
        if (slice < 4) { bf16* op_ = NUM + row_ * 512; _Pragma("unroll") for (int q4 = 0; q4 < 4; ++q4) { v2u w_; \
            w_.x = cvtpk(FC * PV[4 * q4 + 0] + WI * QC[4 * q4 + 0], FC * PV[4 * q4 + 1] + WI * QC[4 * q4 + 1]); w_.y = cvtpk(FC * PV[4 * q4 + 2] + WI * QC[4 * q4 + 2], FC * PV[4 * q4 + 3] + WI * QC[4 * q4 + 3]); *(v2u*)(op_ + 8 * q4) = w_; } } \
        else if (hh == 0) DEN[row_ * 4] = FC * PV[0] + WI * QC[0]; } while (0)
__device__ __forceinline__ void ml_glds16(const void* gsrc, unsigned lds_dst) { unsigned keep;
    asm volatile("s_mov_b32 %0, m0\n\ts_mov_b32 m0, %2\n\ts_nop 0\n\tglobal_load_lds_dwordx4 %1, off\n\ts_mov_b32 m0, %0" : "=&s"(keep) : "v"(gsrc), "s"(lds_dst) : "memory"); }
template <int DIR> __device__ __forceinline__ void mlstm_block_d(const Args& a, int item, LAS unsigned char* L, int wave, int lane_in) {
    int lane = lane_in; asm volatile("" : "+v"(lane));
    unsigned char* ws = a.ws;
    const int h = (item >> 1) & 3, b = item >> 3;
    const int tl = lane & 31, hh = lane >> 5, slice = wave;
    const unsigned loff = (unsigned)lane * 16u;
    const char* base4 = (wave < 4) ? (const char*)(ws + WS_MQK) + (size_t)(wave >> 1) * ((size_t)T * 1024) : (const char*)a.out + (size_t)((wave - 4) >> 1) * ((size_t)T * 1024);
    const char* srcb = base4 + (size_t)(b * 4 + h) * 524288 + (wave & 1) * 8192 + loff;
    const char* scfp = (const char*)(ws + WS_SCF) + (size_t)item * 32 * 1024 + loff;
    const unsigned lds0 = (unsigned)(uintptr_t)L;
    bf16* NUM = (bf16*)(ws + WS_NUM) + (size_t)DIR * T * 512 + h * 128 + 32 * (slice & 3) + 4 * hh;
    float* DEN = (float*)(ws + WS_DEN) + (size_t)DIR * T * 4 + h;
    constexpr int tA = DIR ? 1 : 0, tB = 1 - tA;
#define ML_ISSUE(TC, BUFO) do { _Pragma("unroll") for (int i_ = 0; i_ < 8; ++i_) ml_glds16(srcb + (size_t)(TC) * 16384 + i_ * 1024, (unsigned)__builtin_amdgcn_readfirstlane(lds0 + (BUFO) + wave * 8192 + i_ * 1024)); \
        if (wave == 7) ml_glds16(scfp + (size_t)(TC) * 1024, (unsigned)__builtin_amdgcn_readfirstlane(lds0 + (BUFO) + 65536)); } while (0)
#define ML_WAITBAR() asm volatile("s_waitcnt vmcnt(0) lgkmcnt(0)\n\ts_barrier" ::: "memory")
    f32x16 C[4];
#pragma unroll
    for (int i = 0; i < 4; ++i) C[i] = (f32x16){};
    if (wave == 5) gate_scan_item(a, item, lane);
    ML_WAITBAR();
    ML_ISSUE(DIR ? 31 : 0, 0);
    ML_WAITBAR();
#pragma nounroll
    for (int c = 0; c < 32; ++c) {
        const int tc = DIR ? 31 - c : c, t0 = tc * 64;
        const int bufo = (c & 1) * ML_BUF;
        if (c + 1 < 32) ML_ISSUE(DIR ? 30 - c : c + 1, ML_BUF - bufo);
        const LAS unsigned char* Lb = L + bufo;
        LAS unsigned char* Lp = L + 2 * ML_BUF;
        bf16x8 vtw[4]; f32x16 qcA = (f32x16){}, qcB = (f32x16){};
        float fcA = 0.f, wiA = 0.f, fcB = 0.f, wiB = 0.f, wold = 0.f;
        LAS float* Ld = (LAS float*)(Lp + 6144);
        if (wave >= 4) {
            __builtin_amdgcn_s_setprio(2);
            if (wave >= 5) {
                const int which = wave - 5, kt_ = (which == 2) ? tB : tA, qt_ = (which == 0) ? tA : tB;
                f32x16 S = (f32x16){};
#pragma unroll
                for (int ks = 0; ks < 8; ++ks) { const bf16x8 kf = *(const LAS bf16x8*)(Lb + 16384 + (kt_ * 8 + ks) * 1024 + loff), qf = *(const LAS bf16x8*)(Lb + (qt_ * 8 + ks) * 1024 + loff); S = MFMA32(kf, qf, S); }
                bf16x8 P0, P1;
                if (which == 1) mask_tile<DIR, false>(S, tl, hh, P0, P1); else mask_tile<DIR, true>(S, tl, hh, P0, P1);
                *(LAS bf16x8*)(Lp + (which * 2 + 0) * 1024 + loff) = P0; *(LAS bf16x8*)(Lp + (which * 2 + 1) * 1024 + loff) = P1;
            }
            const LAS float* Ls = (const LAS float*)(Lb + 65536);
            const int dtd = wave - 4;
#pragma unroll
            for (int k = 0; k < 4; ++k) { const f32x4 w0 = *(const LAS f32x4*)(Ls + 128 + 16 * k + 8 * hh), w1 = *(const LAS f32x4*)(Ls + 128 + 16 * k + 8 * hh + 4); v4u o;
                o.x = cvtpk(w0[0], w0[1]); o.y = cvtpk(w0[2], w0[3]); o.z = cvtpk(w1[0], w1[1]); o.w = cvtpk(w1[2], w1[3]); vtw[k] = __builtin_bit_cast(bf16x8, o); }
            fcA = Ls[32 * tA + tl]; wiA = Ls[64 + 32 * tA + tl]; fcB = Ls[32 * tB + tl]; wiB = Ls[64 + 32 * tB + tl]; wold = Ls[192];
            asm volatile("s_nop 15\n\ts_nop 7" : "+v"(C[0]));
#pragma unroll
            for (int s2 = 0; s2 < 2; ++s2) { v4u w_;
                w_.x = cvtpk(C[0][8 * s2 + 0], C[0][8 * s2 + 1]); w_.y = cvtpk(C[0][8 * s2 + 2], C[0][8 * s2 + 3]); w_.z = cvtpk(C[0][8 * s2 + 4], C[0][8 * s2 + 5]); w_.w = cvtpk(C[0][8 * s2 + 6], C[0][8 * s2 + 7]);
                const bf16x8 cfr = __builtin_bit_cast(bf16x8, w_);
                const bf16x8 qfa = *(const LAS bf16x8*)(Lb + (tA * 8 + 2 * dtd + s2) * 1024 + loff), qfb = *(const LAS bf16x8*)(Lb + (tB * 8 + 2 * dtd + s2) * 1024 + loff);
                qcA = MFMA32(cfr, qfa, qcA); qcB = MFMA32(cfr, qfb, qcB); }
            if (hh == 0) { Ld[dtd * 64 + tl] = qcA[0]; Ld[dtd * 64 + 32 + tl] = qcB[0]; }
            __builtin_amdgcn_s_setprio(0);
        } else {
            const LAS float* Ls = (const LAS float*)(Lb + 65536);
            {   bf16x8 vt[4]; f32x4 wsv[4][2];
#pragma unroll
                for (int k = 0; k < 4; ++k) {
                    vt[k] = *(const LAS bf16x8*)(Lb + 49152 + (slice * 4 + k) * 1024 + loff);
                    wsv[k][0] = *(const LAS f32x4*)(Ls + 128 + 16 * k + 8 * hh); wsv[k][1] = *(const LAS f32x4*)(Ls + 128 + 16 * k + 8 * hh + 4);
                }
#pragma unroll
                for (int k = 0; k < 4; ++k) { const v4u vv = __builtin_bit_cast(v4u, vt[k]); const f32x4 w0 = wsv[k][0], w1 = wsv[k][1]; v4u o;
                    o.x = cvtpk(bflo(vv.x) * w0[0], bfhi(vv.x) * w0[1]); o.y = cvtpk(bflo(vv.y) * w0[2], bfhi(vv.y) * w0[3]);
                    o.z = cvtpk(bflo(vv.z) * w1[0], bfhi(vv.z) * w1[1]); o.w = cvtpk(bflo(vv.w) * w1[2], bfhi(vv.w) * w1[3]); vtw[k] = __builtin_bit_cast(bf16x8, o); }
            }
            fcA = Ls[32 * tA + tl]; wiA = Ls[64 + 32 * tA + tl]; fcB = Ls[32 * tB + tl]; wiB = Ls[64 + 32 * tB + tl]; wold = Ls[192];
            asm volatile("s_nop 15\n\ts_nop 7" : "+v"(C[0]), "+v"(C[1]), "+v"(C[2]), "+v"(C[3]));
#pragma unroll
            for (int ks = 0; ks < 8; ++ks) { const bf16x8 qf = *(const LAS bf16x8*)(Lb + (tA * 8 + ks) * 1024 + loff); qcA = MFMA32(CFRAG(ks), qf, qcA); if ((ks & 3) == 3) CBAR(); }
#pragma unroll
            for (int ks = 0; ks < 8; ++ks) { const bf16x8 qf = *(const LAS bf16x8*)(Lb + (tB * 8 + ks) * 1024 + loff); qcB = MFMA32(CFRAG(ks), qf, qcB); if ((ks & 3) == 3) CBAR(); }
        }
        asm volatile("s_waitcnt lgkmcnt(0)\n\ts_barrier" ::: "memory");
        if (wave < 4) {
            bf16x8 P[6];
#pragma unroll
            for (int i = 0; i < 6; ++i) P[i] = *(const LAS bf16x8*)(Lp + i * 1024 + loff);
            {   f32x16 pv = (f32x16){}; pv = MFMA32(vtw[2 * tA + 0], P[0], pv); pv = MFMA32(vtw[2 * tA + 1], P[1], pv);
                STORE_NUM(pv, qcA, fcA, wiA, tA); }
            {   f32x16 pv = (f32x16){}; pv = MFMA32(vtw[2 * tA + 0], P[2], pv); pv = MFMA32(vtw[2 * tA + 1], P[3], pv); pv = MFMA32(vtw[2 * tB + 0], P[4], pv); pv = MFMA32(vtw[2 * tB + 1], P[5], pv);
                STORE_NUM(pv, qcB, fcB, wiB, tB); }
#pragma unroll
            for (int dt = 0; dt < 4; ++dt) C[dt] = C[dt] * wold;
#pragma unroll
            for (int k = 0; k < 4; ++k)
#pragma unroll
                for (int dt = 0; dt < 4; ++dt) { const bf16x8 kt = *(const LAS bf16x8*)(Lb + 32768 + (dt * 4 + k) * 1024 + loff); C[dt] = MFMA32(kt, vtw[k], C[dt]); }
        } else {
            const int dtd = wave - 4;
            if (wave == 4) {
                bf16x8 P[6];
#pragma unroll
                for (int i = 0; i < 6; ++i) P[i] = *(const LAS bf16x8*)(Lp + i * 1024 + loff);
                f32x16 pa = (f32x16){}, pb = (f32x16){};
                pa = MFMA32(vtw[2 * tA + 0], P[0], pa); pa = MFMA32(vtw[2 * tA + 1], P[1], pa);
                pb = MFMA32(vtw[2 * tA + 0], P[2], pb); pb = MFMA32(vtw[2 * tA + 1], P[3], pb); pb = MFMA32(vtw[2 * tB + 0], P[4], pb); pb = MFMA32(vtw[2 * tB + 1], P[5], pb);
                const float qna = (Ld[tl] + Ld[64 + tl]) + (Ld[128 + tl] + Ld[192 + tl]), qnb = (Ld[32 + tl] + Ld[96 + tl]) + (Ld[160 + tl] + Ld[224 + tl]);
                if (hh == 0) { DEN[((size_t)b * SEQ + t0 + 32 * tA + tl) * 4] = fcA * pa[0] + wiA * qna; DEN[((size_t)b * SEQ + t0 + 32 * tB + tl) * 4] = fcB * pb[0] + wiB * qnb; }
            }
            C[0] = C[0] * wold;
#pragma unroll
            for (int k = 0; k < 4; ++k) { const bf16x8 kt = *(const LAS bf16x8*)(Lb + 32768 + (dtd * 4 + k) * 1024 + loff); C[0] = MFMA32(kt, vtw[k], C[0]); }
        }
        ML_WAITBAR();
    }
}
__device__ __forceinline__ void mlstm_block(const Args& a, int item, LAS unsigned char* L, int wave, int lane) {
    if (item & 1) mlstm_block_d<1>(a, item, L, wave, lane); else mlstm_block_d<0>(a, item, L, wave, lane);
}

__device__ __forceinline__ void finalize_mem(const Args& a, int gw, int NGW, int lane_in) {
    int lane = lane_in; asm volatile("" : "+v"(lane));
    unsigned char* ws = a.ws;
    const bf16* NUM = (const bf16*)(ws + WS_NUM); const float* DEN = (const float*)(ws + WS_DEN); const float* SC = (const float*)(ws + WS_SC);
    const bf16* OPRE = (const bf16*)(ws + WS_OPRE); bf16* MEM = (bf16*)((unsigned char*)a.out + OUT_AM) + (size_t)T * 512; const float* hn = a.in[11];
    const int hd = lane >> 4;
    const f32x4 w0 = *(const f32x4*)(hn + lane * 8), w1 = *(const f32x4*)(hn + lane * 8 + 4);
    for (int m0 = gw * 2; m0 < T; m0 += NGW * 2) {
        v4u nf[2], nb[2], ov[2]; float df[2], db[2], clf[2], clb[2];
#pragma unroll
        for (int q = 0; q < 2; ++q) { const int m = m0 + q; const int b = m >> 11, t = m & (SEQ - 1);
            nf[q] = *(const v4u*)(NUM + (size_t)m * 512 + lane * 8); nb[q] = *(const v4u*)(NUM + (size_t)T * 512 + (size_t)m * 512 + lane * 8);
            df[q] = DEN[(size_t)m * 4 + hd]; db[q] = DEN[(size_t)T * 4 + (size_t)m * 4 + hd];
            clf[q] = SC[(size_t)((b * 4 + hd) * 2 + 0) * 5 * SEQ + 3 * SEQ + t]; clb[q] = SC[(size_t)((b * 4 + hd) * 2 + 1) * 5 * SEQ + 3 * SEQ + t];
            ov[q] = *(const v4u*)(OPRE + (size_t)m * 512 + lane * 8); }
#pragma unroll
        for (int q = 0; q < 2; ++q) { const int m = m0 + q;
            const float rf = 1.0f / fmaxf(fabsf(df[q]), clf[q]), rb = 1.0f / fmaxf(fabsf(db[q]), clb[q]);
            float hv[8];
            hv[0] = bflo(nf[q].x) * rf + bflo(nb[q].x) * rb; hv[1] = bfhi(nf[q].x) * rf + bfhi(nb[q].x) * rb; hv[2] = bflo(nf[q].y) * rf + bflo(nb[q].y) * rb; hv[3] = bfhi(nf[q].y) * rf + bfhi(nb[q].y) * rb;
            hv[4] = bflo(nf[q].z) * rf + bflo(nb[q].z) * rb; hv[5] = bfhi(nf[q].z) * rf + bfhi(nb[q].z) * rb; hv[6] = bflo(nf[q].w) * rf + bflo(nb[q].w) * rb; hv[7] = bfhi(nf[q].w) * rf + bfhi(nb[q].w) * rb;
            float ss = 0.f;
#pragma unroll
            for (int i = 0; i < 8; ++i) ss += hv[i] * hv[i];
#pragma unroll
            for (int o = 1; o < 16; o <<= 1) ss += __shfl_xor(ss, o);
            const float rinv = rsqrtf(ss * (1.0f / 128.0f) + EPS);
            v4u o; o.x = pk2(hv[0] * rinv * w0[0] * bflo(ov[q].x), hv[1] * rinv * w0[1] * bfhi(ov[q].x)); o.y = pk2(hv[2] * rinv * w0[2] * bflo(ov[q].y), hv[3] * rinv * w0[3] * bfhi(ov[q].y));
            o.z = pk2(hv[4] * rinv * w1[0] * bflo(ov[q].z), hv[5] * rinv * w1[1] * bfhi(ov[q].z)); o.w = pk2(hv[6] * rinv * w1[2] * bflo(ov[q].w), hv[7] * rinv * w1[3] * bfhi(ov[q].w));
            *(v4u*)(MEM + (size_t)m * 512 + lane * 8) = o; }
    }
}
__device__ __forceinline__ void final_norm(const Args& a, int gw, int NGW, int lane_in) {
    int lane = lane_in; asm volatile("" : "+v"(lane));
    const float* SS3 = (const float*)(a.ws + WS_SS3); const float* fnw = a.in[19]; const bf16* XB = (const bf16*)(a.ws + WS_XB);
    f32x4 w[4];
    w[0] = *(const f32x4*)(fnw + 8 * lane); w[1] = *(const f32x4*)(fnw + 8 * lane + 4); w[2] = *(const f32x4*)(fnw + 512 + 8 * lane); w[3] = *(const f32x4*)(fnw + 512 + 8 * lane + 4);
    for (int m0 = gw * 4; m0 < T; m0 += NGW * 4) {
        v4u v[4][2]; float r[4];
#pragma unroll
        for (int q = 0; q < 4; ++q) { r[q] = SS3[m0 + q]; const bf16* p = XB + (size_t)(m0 + q) * DM + 8 * lane; v[q][0] = *(const v4u*)p; v[q][1] = *(const v4u*)(p + 512); }
#pragma unroll
        for (int q = 0; q < 4; ++q) { const float rr = rsqrtf(r[q] * (1.0f / 1024.0f) + EPS); float* o = a.out + (size_t)(m0 + q) * DM + 8 * lane;
#pragma unroll
            for (int hlf = 0; hlf < 2; ++hlf) { const v4u x = v[q][hlf];
                const f32x4 y0 = (f32x4){bflo(x.x), bfhi(x.x), bflo(x.y), bfhi(x.y)} * rr * w[2 * hlf], y1 = (f32x4){bflo(x.z), bfhi(x.z), bflo(x.w), bfhi(x.w)} * rr * w[2 * hlf + 1];
                *(f32x4*)(o + 512 * hlf) = y0; *(f32x4*)(o + 512 * hlf + 4) = y1; } }
    }
}

#define XB_TMO      128
#define XB_XCNT(j)  (256  + 64 * (j))
#define XB_XSUB(j)  (1280 + 64 * (j))
#define XB_XGEN(j)  (2304 + 64 * (j))
#define XB_TOP      3328
#define XB_TOPGEN   3392
#define XCD_BAR_WORDS 3456
#define XB_SPIN_CAP (1u << 18)

__device__ __forceinline__ unsigned xb_ld(unsigned* p)              { return __hip_atomic_load(p, __ATOMIC_RELAXED, __HIP_MEMORY_SCOPE_AGENT); }
__device__ __forceinline__ unsigned xb_add(unsigned* p, unsigned v) { return __hip_atomic_fetch_add(p, v, __ATOMIC_RELAXED, __HIP_MEMORY_SCOPE_AGENT); }
__device__ __forceinline__ unsigned xb_xcc_id() { return (unsigned)__builtin_amdgcn_s_getreg((3 << 11) | 20) & 0xFu; }
#define XB_SPIN(cond, bar) do { unsigned _sp = 0; while (cond) { __builtin_amdgcn_s_sleep(1); \
    if ((++_sp & 255u) == 0u) { if (xb_ld(&(bar)[XB_TMO])) break; if (_sp > XB_SPIN_CAP) { atomicAdd(&(bar)[XB_TMO], 1u); break; } } } } while (0)

struct XcdBarrier {
    unsigned* bar; unsigned x;
    volatile LAS unsigned* st;
};

__device__ __forceinline__ XcdBarrier xcd_barrier_post(unsigned* bar, volatile LAS unsigned* st) {
    XcdBarrier b; b.bar = bar; b.x = xb_xcc_id(); b.st = st;
    if (threadIdx.x == 0) (void)xb_add(&bar[XB_XCNT(b.x)], 1u);
    return b;
}
__device__ __forceinline__ void xcd_barrier_complete(unsigned* bar, unsigned x, unsigned& nloc, unsigned& nx) {
    const unsigned G = gridDim.x * gridDim.y * gridDim.z;
    unsigned sum, cnt, mine, sp = 0u;
    for (;;) {
        sum = 0u; cnt = 0u; mine = 0u;
#pragma unroll
        for (unsigned j = 0; j < 16; ++j) { const unsigned c = xb_ld(&bar[XB_XCNT(j)]); sum += c; cnt += (c > 0u) ? 1u : 0u; mine = (j == x) ? c : mine; }
        if (sum == G) break;
        __builtin_amdgcn_s_sleep(1);
        if ((++sp & 255u) == 0u) { if (xb_ld(&bar[XB_TMO])) break; if (sp > XB_SPIN_CAP) { atomicAdd(&bar[XB_TMO], 1u); break; } }
    }
    nloc = mine > 0u ? mine : 1u; nx = cnt > 0u ? cnt : 1u;
}

__device__ __forceinline__ void xcd_barrier(const XcdBarrier& b) {
    asm volatile("s_waitcnt vmcnt(0)" ::: "memory");
    __syncthreads();
    if (threadIdx.x == 0) {
        unsigned* bar = b.bar;
        __builtin_amdgcn_s_waitcnt(0);
        unsigned nloc = b.st[0], nx = b.st[1];
        if (nloc == 0u) { xcd_barrier_complete(bar, b.x, nloc, nx); b.st[0] = nloc; b.st[1] = nx; }
        const unsigned old = xb_add(&bar[XB_XSUB(b.x)], 1u);
        const unsigned gen = old / nloc;
        if (old + 1u == (gen + 1u) * nloc) {
            __builtin_amdgcn_fence(__ATOMIC_RELEASE, "agent");
            asm volatile("s_waitcnt vmcnt(0)" ::: "memory");
            const unsigned og = xb_add(&bar[XB_TOP], 1u);
            const unsigned tg = og / nx;
            if (og + 1u == (tg + 1u) * nx) xb_add(&bar[XB_TOPGEN], 1u);
            else XB_SPIN(xb_ld(&bar[XB_TOPGEN]) == tg, bar);
            __builtin_amdgcn_fence(__ATOMIC_ACQUIRE, "agent");
            xb_add(&bar[XB_XGEN(b.x)], 1u);
            asm volatile("s_waitcnt vmcnt(0)" ::: "memory");
        } else {
            XB_SPIN(xb_ld(&bar[XB_XGEN(b.x)]) == gen, bar);
            __builtin_amdgcn_fence(__ATOMIC_ACQUIRE, "agent");
            asm volatile("s_waitcnt vmcnt(0)" ::: "memory");
        }
    }
    __syncthreads();
}

__global__ void __launch_bounds__(NWAVES * 64, 2) mega_fwd(Args args) {
    extern __shared__ __attribute__((aligned(16))) unsigned char lds[];
    cg::grid_group grid = cg::this_grid();
    LAS unsigned char* L = (LAS unsigned char*)lds;
    volatile LAS unsigned* MISC = (volatile LAS unsigned*)(L + MISC_OFF);
    const int tid = threadIdx.x, lane = tid & 63, wave = __builtin_amdgcn_readfirstlane(tid >> 6);
    const int G = gridDim.x; const int bx = blockIdx.x;
    const int vcu = (G % 8 == 0) ? (bx % 8) * (G / 8) + bx / 8 : bx;
    const int gw = vcu * NWAVES + wave, NGW = G * NWAVES;
    unsigned char* ws = args.ws;
    for (int u = tid; u < 64; u += NWAVES * 64) ((LAS unsigned*)(L + MISC_OFF))[u] = 0u;
    __syncthreads();
    const XcdBarrier xbar = xcd_barrier_post((unsigned*)(ws + WS_CTL) + CW_BAR, MISC + 8);
    if (args.ws == nullptr) grid.sync();
#define GSYNC() xcd_barrier(xbar)
    bf16* XB = (bf16*)(ws + WS_XB); bf16* Hb = (bf16*)(ws + WS_H); bf16* WIN = (bf16*)(ws + WS_WIN);

#define EPI_INIT(E) do { E.ssin = nullptr; E.ssout = nullptr; E.x0 = args.in[0]; E.x1 = args.in[1]; E.f32buf = args.out; E.b0 = nullptr; E.q = (bf16*)(ws + WS_QB); E.kv = (bf16*)(ws + WS_KV); \
    E.mqk = (bf16*)(ws + WS_MQK); E.opre = (bf16*)(ws + WS_OPRE); E.g16 = (float*)(ws + WS_G16); E.gate = nullptr; E.qnw = args.in[8]; E.knw = args.in[9]; E.ropec = (const float*)(ws + WS_ROPEC); E.ropes = (const float*)(ws + WS_ROPES); } while (0)
#define RUN_GEMM(EPI_T, E, Aptr, Bptr, Mv, Nv, Kv) do { pg8::Gemm g; g.A = (Aptr); g.Bt = (Bptr); g.M = (Mv); g.N = (Nv); g.K = (Kv); pg8::StaticOrder S; S.init(g.M, g.N, G, bx); \
    pg8::gemm_phase<EPI_T, pg8::StaticOrder, true, true>(L, g, S, E); } while (0)
    p0_prologue(args, L, gw, NGW, wave, lane);
    GSYNC();
    { typedef pg8::EpiG<pg8::M_SWIGLU> EP; EP E; EPI_INIT(E); E.ssin = (float*)(ws + WS_SS0); E.b0 = Hb; RUN_GEMM(EP, E, XB, (bf16*)(ws + WS_W1GU), T, 2 * DFF, DM); }
    GSYNC();
    { typedef pg8::EpiG<pg8::M_RES, 1, 0, 1> EP; EP E; EPI_INIT(E); E.b0 = XB; E.ssout = (float*)(ws + WS_SS1);     RUN_GEMM(EP, E, Hb, (bf16*)(ws + WS_W1D), T, DM, DFF); }
    GSYNC();
    { typedef pg8::EpiG<pg8::M_WINA> EP; EP E; EPI_INIT(E); E.ssin = (float*)(ws + WS_SS1); RUN_GEMM(EP, E, XB, WIN, T, 2560, DM); }
    { typedef pg8::EpiG<pg8::M_KVT> EP; EP E; EPI_INIT(E); E.ssin = (float*)(ws + WS_SS1); E.b0 = (bf16*)args.out; RUN_GEMM(EP, E, WIN + (size_t)2048 * DM, XB, 1024, T, DM); }
    GSYNC();
    {
        unsigned* qctr = (unsigned*)(ws + WS_CTL);
        for (;;) {
            if (tid == 0) MISC[0] = __hip_atomic_fetch_add(qctr, 1u, __ATOMIC_RELAXED, __HIP_MEMORY_SCOPE_AGENT);
            __syncthreads();
            const int u = __builtin_amdgcn_readfirstlane((int)MISC[0]);
            __syncthreads();
            if (u >= N_MLSTM_BLK + N_ATT_UNITS) break;
            if (u < N_MLSTM_BLK) { mlstm_block(args, u, L, wave, lane); }
            else { const int au = u - N_MLSTM_BLK; const int qb = au & 7, gq = (au >> 3) & 3, kvh = (au >> 5) & 1, b = au >> 6;
                attn_body::attn_unit<8>(b, kvh * 4 + gq, qb, (const attn_body::bf16*)(ws + WS_QB), (const attn_body::bf16*)(ws + WS_KV), (const attn_body::bf16*)(ws + WS_KV) + 128, (attn_body::bf16*)((unsigned char*)args.out + OUT_AM), (char*)lds); }
        }
    }
    GSYNC();
    { typedef pg8::EpiG<pg8::M_GAGM> EP; EP E; EPI_INIT(E); E.ssin = (float*)(ws + WS_SS1); E.b0 = (bf16*)(ws + WS_GA); E.gate = (bf16*)args.out; RUN_GEMM(EP, E, XB, WIN + (size_t)3072 * DM, T, 2048, DM); }
    finalize_mem(args, gw, NGW, lane);
    GSYNC();
    { typedef pg8::EpiG<pg8::M_UPF> EP; EP E; EPI_INIT(E); E.q = (bf16*)(ws + WS_GA); E.gate = (bf16*)args.out; E.b0 = (bf16*)(ws + WS_MERGED); { pg8::Gemm g; g.A = (bf16*)((unsigned char*)args.out + OUT_AM); g.Bt = (bf16*)(ws + WS_WA); g.M = T; g.N = DM; g.K = 512; pg8::HalfOrder S; S.init(T, DM, G, bx);
        pg8::gemm_phase<EP, pg8::HalfOrder, true, true>(L, g, S, E); } }
    GSYNC();
    { typedef pg8::EpiG<pg8::M_RES, 1, 0, 1> EP; EP E; EPI_INIT(E); E.b0 = XB; E.ssout = (float*)(ws + WS_SS2); RUN_GEMM(EP, E, (bf16*)(ws + WS_MERGED), (bf16*)(ws + WS_WOUT), T, DM, DM); }
    GSYNC();
    { typedef pg8::EpiG<pg8::M_SWIGLU> EP; EP E; EPI_INIT(E); E.ssin = (float*)(ws + WS_SS2); E.b0 = Hb; RUN_GEMM(EP, E, XB, (bf16*)(ws + WS_W2GU), T, 2 * DFF, DM); }
    GSYNC();
    { typedef pg8::EpiG<pg8::M_RES, 1, 0, 1> EP; EP E; EPI_INIT(E); E.b0 = XB; E.ssout = (float*)(ws + WS_SS3); RUN_GEMM(EP, E, Hb, (bf16*)(ws + WS_W2D), T, DM, DFF); }
    GSYNC();
    final_norm(args, gw, NGW, lane);
}

extern "C" void kernel_launch(void* const* d_in, const int* in_sizes, int n_in, void* d_out, int out_size, void* d_ws, size_t ws_size, hipStream_t stream) {
    static int grid = 0;
    if (grid == 0) {
        int dev = 0, cus = 0, per_cu = 0;
        if (n_in != 20 || out_size != T * DM || ws_size < WS_END) { fprintf(stderr, "kernel_launch: unexpected shapes n_in %d out %d ws %zu\n", n_in, out_size, ws_size); grid = -1; return; }
        (void)hipGetDevice(&dev);
        (void)hipDeviceGetAttribute(&cus, hipDeviceAttributeMultiprocessorCount, dev);
        (void)hipFuncSetAttribute((const void*)mega_fwd, hipFuncAttributeMaxDynamicSharedMemorySize, LDS_BYTES);
        (void)hipOccupancyMaxActiveBlocksPerMultiprocessor(&per_cu, (const void*)mega_fwd, NWAVES * 64, LDS_BYTES);
        if (per_cu < 1) per_cu = 1;
        if (per_cu > 1) per_cu = 1;
        grid = cus * per_cu;
        fprintf(stderr, "kernel_launch: grid %d ws %zu\n", grid, ws_size);
    }
    if (grid < 0) return;
    (void)hipMemsetAsync((char*)d_ws + WS_CTL, 0, CTL_ZERO_BYTES, stream);
    Args a{};
    for (int i = 0; i < 20; ++i) a.in[i] = (const float*)d_in[i];
    a.out = (float*)d_out; a.ws = (unsigned char*)d_ws;
    void* kargs[] = {&a};
    hipError_t e = hipLaunchCooperativeKernel((void*)mega_fwd, dim3(grid), dim3(NWAVES * 64), kargs, LDS_BYTES, stream);
    if (e != hipSuccess) fprintf(stderr, "kernel_launch: cooperative launch failed: %s (grid %d)\n", hipGetErrorString(e), grid);
}
```
